# Optimizing an MI355X kernel written in HIP

```python
import math
import jax, jax.numpy as jnp
from jax import lax
import numpy as np

D_MODEL = 1024
BATCH = 32
SEQ = 2048
DEPTH = 2

HEAD_DIM = 64
SB_HEADS = 8
MB_HEADS = 8
SB_W = SB_HEADS * HEAD_DIM
MB_W = MB_HEADS * HEAD_DIM
CONV_CH = D_MODEL // 2
CONV_WIDTH = 31
MOBA_BLOCK = 256
MOBA_TOPK = 3
Q_BLOCK = 128
MOBA_Q_CHUNK = 32
D_FF = 2816
N_BRANCH = 3
EPS = 1e-6

OFF_SBQ = 0
OFF_SBK = OFF_SBQ + SB_W
OFF_SBV = OFF_SBK + SB_W
OFF_MBQ = OFF_SBV + SB_W
OFF_MBK = OFF_MBQ + MB_W
OFF_MBV = OFF_MBK + MB_W
OFF_CONV = OFF_MBV + MB_W
OFF_GATE = OFF_CONV + 2 * CONV_CH
IN_COLS = OFF_GATE + N_BRANCH * D_MODEL

kernel_name = "hybrid_stickbreak_moba_conformer_macaron"


def rmsnorm(x, g):
    xf = x.astype(jnp.float32)
    y = xf * lax.rsqrt(jnp.mean(xf * xf, axis=-1, keepdims=True) + EPS)
    return (y * g.astype(jnp.float32)).astype(x.dtype)


def layernorm(x, g, b):
    xf = x.astype(jnp.float32)
    mu = jnp.mean(xf, axis=-1, keepdims=True)
    var = jnp.mean(jnp.square(xf - mu), axis=-1, keepdims=True)
    y = (xf - mu) * lax.rsqrt(var + EPS)
    return (y * g.astype(jnp.float32) + b.astype(jnp.float32)).astype(x.dtype)


def swiglu(x, w_in, w_out):
    a = x @ w_in
    return (jax.nn.silu(a[..., :D_FF]) * a[..., D_FF:]) @ w_out


def to_heads(a, n_heads):
    b, s, _ = a.shape
    return a.reshape(b, s, n_heads, HEAD_DIM).transpose(0, 2, 1, 3)


def from_heads(a):
    b, h, s, d = a.shape
    return a.transpose(0, 2, 1, 3).reshape(b, s, h * d)


def stick_breaking_attention(q, k, v):
    B, H, S, Dh = q.shape
    n_blk = -(-S // Q_BLOCK)
    s_pad = n_blk * Q_BLOCK
    qp = jnp.pad(q, ((0, 0), (0, 0), (0, s_pad - S), (0, 0)))
    scale = HEAD_DIM ** -0.5
    key_pos = jnp.arange(S)

    def block(start):
        qb = lax.dynamic_slice_in_dim(qp, start, Q_BLOCK, axis=2)
        t = start + jnp.arange(Q_BLOCK)
        z = jnp.einsum('bhqd,bhkd->bhqk', qb, k).astype(jnp.float32) * scale
        past = key_pos[None, :] < t[:, None]
        log_beta = jax.nn.log_sigmoid(z)
        log_1m = jnp.where(past, jax.nn.log_sigmoid(-z), 0.0)
        between = lax.cumsum(log_1m, axis=3, reverse=True) - log_1m
        w = jnp.where(past, jnp.exp(log_beta + between), 0.0)
        return jnp.einsum('bhqk,bhkd->bhqd', w.astype(v.dtype), v)

    starts = jnp.arange(n_blk, dtype=jnp.int32) * Q_BLOCK
    out = lax.map(block, starts)
    out = out.transpose(1, 2, 0, 3, 4).reshape(B, H, s_pad, Dh)
    return out[:, :, :S]


def moba_attention(q, k, v, slopes):
    B, H, S, Dh = q.shape
    nb = -(-S // MOBA_BLOCK)
    s_pad = nb * MOBA_BLOCK
    pad = ((0, 0), (0, 0), (0, s_pad - S), (0, 0))
    qp, kp, vp = jnp.pad(q, pad), jnp.pad(k, pad), jnp.pad(v, pad)
    kblk = kp.reshape(B, H, nb, MOBA_BLOCK, Dh)
    vblk = vp.reshape(B, H, nb, MOBA_BLOCK, Dh)
    kmean = jnp.mean(kblk.astype(jnp.float32), axis=3)
    n_sel = min(MOBA_TOPK, nb - 1)
    scale = HEAD_DIM ** -0.5
    bi = jnp.arange(B)[:, None, None, None]
    hi = jnp.arange(H)[None, :, None, None]
    blk_pos = jnp.arange(MOBA_BLOCK)

    def chunk(start):
        own = start // MOBA_BLOCK
        qb = lax.dynamic_slice_in_dim(qp, start, MOBA_Q_CHUNK, axis=2)
        t = start + jnp.arange(MOBA_Q_CHUNK)
        k_own = lax.dynamic_index_in_dim(kblk, own, axis=2, keepdims=False)
        v_own = lax.dynamic_index_in_dim(vblk, own, axis=2, keepdims=False)
        s_own = own * MOBA_BLOCK + blk_pos
        dist_own = (t[:, None] - s_own[None, :]).astype(jnp.float32)
        sc_own = (jnp.einsum('bhqd,bhkd->bhqk', qb, k_own).astype(jnp.float32) * scale
                  - slopes[:, None, None] * dist_own)
        sc_own = jnp.where(s_own[None, :] <= t[:, None], sc_own, -jnp.inf)
        if n_sel > 0:
            gate = jnp.einsum('bhqd,bhnd->bhqn', qb.astype(jnp.float32), kmean)
            gate = jnp.where(jnp.arange(nb) < own, gate, -jnp.inf)
            _, idx = lax.top_k(gate, n_sel)
            k_sel = kblk[bi, hi, idx]
            v_sel = vblk[bi, hi, idx]
            s_sel = idx[..., None] * MOBA_BLOCK + blk_pos
            dist_sel = (t[:, None, None] - s_sel).astype(jnp.float32)
            sc_sel = (jnp.einsum('bhqd,bhqnkd->bhqnk', qb, k_sel).astype(jnp.float32) * scale
                      - slopes[:, None, None, None] * dist_sel)
            sc_sel = jnp.where((idx < own)[..., None], sc_sel, -jnp.inf)
            n_k = n_sel * MOBA_BLOCK
            sc = jnp.concatenate([sc_sel.reshape(B, H, MOBA_Q_CHUNK, n_k), sc_own], axis=-1)
            p = jax.nn.softmax(sc, axis=-1).astype(v.dtype)
            p_sel = p[..., :n_k].reshape(B, H, MOBA_Q_CHUNK, n_sel, MOBA_BLOCK)
            o = (jnp.einsum('bhqnk,bhqnkd->bhqd', p_sel, v_sel)
                 + jnp.einsum('bhqk,bhkd->bhqd', p[..., n_k:], v_own))
        else:
            p = jax.nn.softmax(sc_own, axis=-1).astype(v.dtype)
            o = jnp.einsum('bhqk,bhkd->bhqd', p, v_own)
        return o

    n_chunks = s_pad // MOBA_Q_CHUNK
    starts = jnp.arange(n_chunks, dtype=jnp.int32) * MOBA_Q_CHUNK
    out = lax.map(chunk, starts)
    out = out.transpose(1, 2, 0, 3, 4).reshape(B, H, s_pad, Dh)
    return out[:, :, :S]


def conformer_conv(a, w_dw, b_dw, ln_g, ln_b, w_pw):
    h = a[..., :CONV_CH] * jax.nn.sigmoid(a[..., CONV_CH:])
    h = lax.conv_general_dilated(h, w_dw, window_strides=(1,),
                                 padding=[(CONV_WIDTH - 1, 0)],
                                 dimension_numbers=('NWC', 'WIO', 'NWC'),
                                 feature_group_count=CONV_CH) + b_dw
    h = jax.nn.silu(layernorm(h, ln_g, ln_b))
    return h @ w_pw


def alibi_slopes(n_heads):
    return jnp.exp2(-8.0 * jnp.arange(1, n_heads + 1, dtype=jnp.float32) / n_heads)


def setup_inputs(seed: int = 0) -> dict:
    key = jax.random.key(seed)
    ks = jax.random.split(key, 24)
    L, D = DEPTH, D_MODEL

    def nrm(k, shape, fan_in):
        return jax.random.normal(k, shape, jnp.float32) * (fan_in ** -0.5)

    def gain(k, shape):
        return 1.0 + 0.02 * jax.random.normal(k, shape, jnp.float32)

    def small(k, shape):
        return 0.01 * jax.random.normal(k, shape, jnp.float32)

    return {
        "x": jax.random.normal(ks[0], (BATCH, SEQ, D), jnp.float32),
        "ffn1_norm": gain(ks[1], (L, D)),
        "ffn1_w_in": nrm(ks[2], (L, D, 2 * D_FF), D),
        "ffn1_w_out": nrm(ks[3], (L, D_FF, D), D_FF),
        "mix_norm": gain(ks[4], (L, D)),
        "w_in": nrm(ks[5], (L, D, IN_COLS), D),
        "gate_bias": small(ks[6], (L, N_BRANCH * D)),
        "sb_w_out": nrm(ks[7], (L, SB_W, D), SB_W),
        "mb_w_out": nrm(ks[8], (L, MB_W, D), MB_W),
        "conv_dw": nrm(ks[9], (L, CONV_WIDTH, 1, CONV_CH), CONV_WIDTH),
        "conv_dw_bias": small(ks[10], (L, CONV_CH)),
        "conv_ln_g": gain(ks[11], (L, CONV_CH)),
        "conv_ln_b": small(ks[12], (L, CONV_CH)),
        "conv_w_out": nrm(ks[13], (L, CONV_CH, D), CONV_CH),
        "w_o": nrm(ks[14], (L, D, D), D),
        "ffn2_norm": gain(ks[15], (L, D)),
        "ffn2_w_in": nrm(ks[16], (L, D, 2 * D_FF), D),
        "ffn2_w_out": nrm(ks[17], (L, D_FF, D), D_FF),
        "final_norm": gain(ks[18], (D,)),
    }


def reference(x, ffn1_norm, ffn1_w_in, ffn1_w_out, mix_norm, w_in, gate_bias,
              sb_w_out, mb_w_out, conv_dw, conv_dw_bias, conv_ln_g, conv_ln_b,
              conv_w_out, w_o, ffn2_norm, ffn2_w_in, ffn2_w_out, final_norm):
    slopes = alibi_slopes(MB_HEADS)
    h = x
    for l in range(DEPTH):
        h = h + 0.5 * swiglu(rmsnorm(h, ffn1_norm[l]), ffn1_w_in[l], ffn1_w_out[l])
        u = rmsnorm(h, mix_norm[l])
        p = u @ w_in[l]
        q_a = to_heads(p[..., OFF_SBQ:OFF_SBK], SB_HEADS)
        k_a = to_heads(p[..., OFF_SBK:OFF_SBV], SB_HEADS)
        v_a = to_heads(p[..., OFF_SBV:OFF_MBQ], SB_HEADS)
        q_b = to_heads(p[..., OFF_MBQ:OFF_MBK], MB_HEADS)
        k_b = to_heads(p[..., OFF_MBK:OFF_MBV], MB_HEADS)
        v_b = to_heads(p[..., OFF_MBV:OFF_CONV], MB_HEADS)
        y_a = from_heads(stick_breaking_attention(q_a, k_a, v_a)) @ sb_w_out[l]
        y_b = from_heads(moba_attention(q_b, k_b, v_b, slopes)) @ mb_w_out[l]
        y_c = conformer_conv(p[..., OFF_CONV:OFF_GATE], conv_dw[l], conv_dw_bias[l],
                             conv_ln_g[l], conv_ln_b[l], conv_w_out[l])
        g = jax.nn.sigmoid(p[..., OFF_GATE:] + gate_bias[l])
        mixed = (g[..., :D_MODEL] * y_a + g[..., D_MODEL:2 * D_MODEL] * y_b
                 + g[..., 2 * D_MODEL:] * y_c)
        h = h + mixed @ w_o[l]
        h = h + 0.5 * swiglu(rmsnorm(h, ffn2_norm[l]), ffn2_w_in[l], ffn2_w_out[l])
    return rmsnorm(h, final_norm)
```

```cpp
#include <hip/hip_runtime.h>
#include <cstdint>
#include <cstdio>

typedef unsigned long long u64;
constexpr int NB = 32, S = 2048, D = 1024, M = NB * S, DEPTH = 2;
constexpr int HD = 64, NH = 8, AW = 512, CC = 512, CW = 31;
constexpr int DFF = 2816, NFF = 2 * DFF, NIN = 7168;
constexpr float EPS = 1e-6f;
constexpr float LOG2E = 1.4426950408889634f, LN2 = 0.6931471805599453f;
constexpr float QSCALE = 0.125f * LOG2E;
constexpr float SSQ_FIX = 16384.f, SSQ_INV = 1.f / 16384.f;

constexpr size_t MiB = 1u << 20;
constexpr size_t WS_CTL = 0, CTL_BYTES = 4 * MiB;
constexpr size_t WS_SSQ = 512 * 1024;
constexpr size_t WS_W = 4 * MiB, W_LAYER = 52 * MiB;
constexpr size_t W_F1I = 0, W_F1O = 11534336, W_IN = 17301504, W_OUT3 = 31981568, W_O = 35127296, W_F2I = 37224448, W_F2O = 48758784;
static_assert(W_F2O + 5767168 == W_LAYER, "weights");
constexpr size_t WS_H = 108 * MiB;
constexpr size_t WS_ACT = 236 * MiB;
constexpr size_t WS_QA = 236 * MiB, WS_KA = 300 * MiB, WS_VA = 364 * MiB, WS_QB = 428 * MiB, WS_KB = 492 * MiB, WS_VB = 556 * MiB;
constexpr size_t WS_CONVO = 620 * MiB, WS_GLU = 684 * MiB, WS_GC = 748 * MiB, WS_KMEAN = 876 * MiB, WS_END = 877 * MiB;
constexpr size_t WS_MIXED = WS_KA;
static_assert(WS_QB - WS_QA == 192 * MiB && WS_CONVO - WS_QB == 192 * MiB, "the three out-projection A operands sit 192 MiB apart (MixOrder)");

namespace pg8 {
#define PG8_LAS __attribute__((address_space(3)))
typedef unsigned short bf16_t;
typedef short bf16x8 __attribute__((ext_vector_type(8)));
typedef float f32x4 __attribute__((ext_vector_type(4)));
typedef unsigned u32x4 __attribute__((ext_vector_type(4)));
constexpr int BM = 256, BK = 64, HALF = 128, HTB = HALF * BK * 2  , STAGE_BYTES = 8 * HTB, NXCD = 8, WGM = 8;

__host__ __device__ __forceinline__ int lds_byte(int r, int c) { const int st = (r >> 4) * 2 + (c >> 5), rr = r & 15, cc = c & 31, ob = rr * 64 + cc * 2; return st * 1024 + (ob ^ (((ob >> 9) & 1) << 5)); }
__host__ __device__ __forceinline__ void stage_rc(int b, int& R, int& C) { const int st = b / 1024, sb = b % 1024, swz = sb ^ (((sb >> 9) & 1) << 5); R = (st >> 1) * 16 + swz / 64; C = (st & 1) * 32 + (swz % 64) / 2; }
__host__ __device__ __forceinline__ int perm32(int rho) { const int n = rho >> 4, i = rho & 15; return 8 * (i >> 2) + 4 * n + (i & 3); }

struct Unit { int pm, pn; };
struct Gemm { const bf16_t* A; const bf16_t* Bt; int M, N, K; };

struct StaticOrder {
    int nM, nN, nwg, G, c;
    __host__ __device__ void init(int M, int N, int G_, int c_) { nM = M / BM; nN = N / BM; nwg = nM * nN; G = G_; c = c_; }
    __host__ __device__ bool next(int i, Unit& u) const {
        const long L = (long)i * G + c; if (L >= nwg) return false;
        int wgid = (int)L; { const int q = nwg / NXCD, r = nwg % NXCD, xcd = wgid % NXCD, off = wgid / NXCD; wgid = (xcd < r ? xcd * (q + 1) : r * (q + 1) + (xcd - r) * q) + off; }
        const int nig = WGM * nN, gid = wgid / nig, fm = gid * WGM, gsz = (nM - fm) < WGM ? (nM - fm) : WGM;
        u.pm = fm + ((wgid % nig) % gsz); u.pn = (wgid % nig) / gsz; return true;
    }
    __device__ __forceinline__ void a_ready(const Unit&) const {}
    __device__ __forceinline__ void done(const Unit&) const {}
};

__device__ __forceinline__ unsigned cvt_pk_bf16(float lo, float hi) { unsigned r; asm volatile("v_cvt_pk_bf16_f32 %0, %1, %2" : "=v"(r) : "v"(lo), "v"(hi)); return r; }
__device__ __forceinline__ float ex2(float x) { return __builtin_amdgcn_exp2f(x); }
__device__ __forceinline__ float rcpf_(float x) { return __builtin_amdgcn_rcpf(x); }
__device__ __forceinline__ float sigm(float x) { return rcpf_(1.f + ex2(-LOG2E * x)); }
__device__ __forceinline__ float bflo(unsigned w) { return __uint_as_float(w << 16); }
__device__ __forceinline__ float bfhi(unsigned w) { return __uint_as_float(w & 0xffff0000u); }
__device__ __forceinline__ u32x4 pack8(const f32x4 a, const f32x4 b) { u32x4 w; w.x = cvt_pk_bf16(a[0], a[1]); w.y = cvt_pk_bf16(a[2], a[3]); w.z = cvt_pk_bf16(b[0], b[1]); w.w = cvt_pk_bf16(b[2], b[3]); return w; }
__device__ __forceinline__ void unpack8(const u32x4 w, f32x4& a, f32x4& b) { a = (f32x4){bflo(w.x), bfhi(w.x), bflo(w.y), bfhi(w.y)}; b = (f32x4){bflo(w.z), bfhi(w.z), bflo(w.w), bfhi(w.w)}; }
__device__ __forceinline__ void st_nt(bf16_t* p, const u32x4 v) { __builtin_nontemporal_store(v, (u32x4*)p); }
typedef unsigned ssq_t;
constexpr int RS_LDS = 131072 + 2048;
struct RowScale {
    const ssq_t* ssq; unsigned p0, p1;
    __device__ __forceinline__ void prefetch(const Unit& u, int wr, int lane) { const ssq_t* s = ssq + u.pm * BM + wr * 64 + lane; p0 = s[0]; p1 = s[HALF]; }
    __device__ __forceinline__ void stash(PG8_LAS unsigned char* lds, int wid, int lane) const { PG8_LAS float* t = (PG8_LAS float*)(lds + RS_LDS) + wid * 128;
        t[lane] = __builtin_amdgcn_rsqf((float)p0 * (SSQ_INV / D) + EPS); t[64 + lane] = __builtin_amdgcn_rsqf((float)p1 * (SSQ_INV / D) + EPS); }
    __device__ __forceinline__ void get(PG8_LAS unsigned char* lds, int wid, int fr, float (&rs)[2][4]) const { const PG8_LAS float* t = (const PG8_LAS float*)(lds + RS_LDS) + wid * 128;
#pragma unroll
        for (int ai = 0; ai < 2; ++ai)
#pragma unroll
            for (int m = 0; m < 4; ++m) rs[ai][m] = t[ai * 64 + m * 16 + fr]; }
};

struct EpiSwiglu {
    static constexpr bool PERM = true, AFTER_DRAIN = false;
    bf16_t* O; RowScale R; PG8_LAS unsigned char* lds;
    __device__ __forceinline__ void prefetch(const Unit& u, int wr, int lane) { R.prefetch(u, wr, lane); }
    __device__ __forceinline__ void stash(int wid, int lane) const { R.stash(lds, wid, lane); }
    __device__ __forceinline__ bool operator()(f32x4 (&acc)[2][2][4][2], const Unit& u, int wr, int wc, int fr, int fq) const {
        const int row0 = u.pm * BM + wr * 64 + fr, col0 = u.pn * HALF + wc * 32 + 8 * fq;
        float rs[2][4]; R.get(lds, wr * 4 + wc, fr, rs);
#pragma unroll
        for (int ai = 0; ai < 2; ++ai)
#pragma unroll
            for (int m = 0; m < 4; ++m) { const float r = rs[ai][m], c1 = -LOG2E * r, r2 = r * r; f32x4 o[2];
#pragma unroll
                for (int n = 0; n < 2; ++n) { const f32x4 a = acc[ai][0][m][n], t = a * c1; f32x4 d;
#pragma unroll
                    for (int k = 0; k < 4; ++k) d[k] = ex2(t[k]);
                    d = d + 1.0f;
#pragma unroll
                    for (int k = 0; k < 4; ++k) d[k] = rcpf_(d[k]);
                    o[n] = (a * acc[ai][1][m][n]) * (d * r2); }
                st_nt(O + (size_t)(row0 + ai * HALF + m * 16) * DFF + col0, pack8(o[0], o[1])); }
        return false;
    }
};
struct EpiRes {
    static constexpr bool PERM = true, AFTER_DRAIN = false;
    bf16_t* Hh; ssq_t* ssq_out; float scale;
    __device__ __forceinline__ void prefetch(const Unit&, int, int) {}
    __device__ __forceinline__ void stash(int, int) const {}
    __device__ __forceinline__ bool operator()(f32x4 (&acc)[2][2][4][2], const Unit& u, int wr, int wc, int fr, int fq) const {
        const int row0 = u.pm * BM + wr * 64 + fr, col0 = u.pn * BM + wc * 32 + 8 * fq;
#pragma unroll
        for (int ai = 0; ai < 2; ++ai) {
            u32x4 hv[4][2];
#pragma unroll
            for (int m = 0; m < 4; ++m)
#pragma unroll
                for (int bj = 0; bj < 2; ++bj) hv[m][bj] = *(const u32x4*)(Hh + (size_t)(row0 + ai * HALF + m * 16) * D + col0 + bj * HALF);
            asm volatile("" ::: "memory");
#pragma unroll
            for (int m = 0; m < 4; ++m) { const int row = row0 + ai * HALF + m * 16; bf16_t* hp = Hh + (size_t)row * D + col0; float sq = 0.f;
#pragma unroll
                for (int bj = 0; bj < 2; ++bj) { f32x4 a, b; unpack8(hv[m][bj], a, b); a += acc[ai][bj][m][0] * scale; b += acc[ai][bj][m][1] * scale;
                    sq += (a[0] * a[0] + a[1] * a[1]) + (a[2] * a[2] + a[3] * a[3]) + (b[0] * b[0] + b[1] * b[1]) + (b[2] * b[2] + b[3] * b[3]);
                    *(u32x4*)(hp + bj * HALF) = pack8(a, b); }
                sq += __shfl_xor(sq, 16); sq += __shfl_xor(sq, 32);
                if (fq == 0) atomicAdd(ssq_out + row, (unsigned)(sq * SSQ_FIX + 0.5f));
            }
            asm volatile("" ::: "memory");
        }
        return false;
    }
};
struct EpiWin {
    static constexpr bool PERM = true, AFTER_DRAIN = false;
    bf16_t* qkv; bf16_t* glu; bf16_t* gA; bf16_t* gB; bf16_t* gC; const float* gbias; RowScale R; PG8_LAS unsigned char* lds;
    __device__ __forceinline__ void prefetch(const Unit& u, int wr, int lane) { R.prefetch(u, wr, lane); }
    __device__ __forceinline__ void stash(int wid, int lane) const { R.stash(lds, wid, lane); }
    __device__ __forceinline__ bool operator()(f32x4 (&acc)[2][2][4][2], const Unit& u, int wr, int wc, int fr, int fq) const {
        const int row0 = u.pm * BM + wr * 64 + fr, pn = u.pn;
        bf16_t* const pA = gA; bf16_t* const pB = gB; bf16_t* const pC = gC;
        float rs[2][4]; R.get(lds, wr * 4 + wc, fr, rs);
        if (pn < 12) {
            const int t = pn >> 1; bf16_t* base = qkv + (size_t)t * (64 * MiB / 2) + (pn & 1) * 256 + wc * 32 + 8 * fq; const float sc = (t == 0 || t == 3) ? QSCALE : 1.f;
#pragma unroll
            for (int ai = 0; ai < 2; ++ai)
#pragma unroll
                for (int m = 0; m < 4; ++m) { const float r = rs[ai][m] * sc; bf16_t* rp = base + (size_t)(row0 + ai * HALF + m * 16) * AW;
#pragma unroll
                    for (int bj = 0; bj < 2; ++bj) st_nt(rp + bj * HALF, pack8(acc[ai][bj][m][0] * r, acc[ai][bj][m][1] * r)); }
        } else if (pn < 16) {
            bf16_t* base = glu + (pn - 12) * HALF + wc * 32 + 8 * fq;
#pragma unroll
            for (int ai = 0; ai < 2; ++ai)
#pragma unroll
                for (int m = 0; m < 4; ++m) { const float r = rs[ai][m]; f32x4 o[2];
#pragma unroll
                    for (int n = 0; n < 2; ++n) { const f32x4 a = acc[ai][0][m][n] * r, g = acc[ai][1][m][n] * r;
#pragma unroll
                        for (int k = 0; k < 4; ++k) o[n][k] = a[k] * sigm(g[k]); }
                    st_nt(base + (size_t)(row0 + ai * HALF + m * 16) * CC, pack8(o[0], o[1])); }
        } else {
            const int X = (pn - 16) >> 2, c0 = ((pn - 16) & 3) * 256 + wc * 32 + 8 * fq; bf16_t* base = pA; if (X == 1) base = pB; if (X == 2) base = pC; base += c0;
            f32x4 bv[2][2];
#pragma unroll
            for (int bj = 0; bj < 2; ++bj)
#pragma unroll
                for (int n = 0; n < 2; ++n) bv[bj][n] = *(const f32x4*)(gbias + X * D + c0 + bj * HALF + 4 * n);
#pragma unroll
            for (int ai = 0; ai < 2; ++ai)
#pragma unroll
                for (int m = 0; m < 4; ++m) { const float r = rs[ai][m]; bf16_t* rp = base + (size_t)(row0 + ai * HALF + m * 16) * D;
#pragma unroll
                    for (int bj = 0; bj < 2; ++bj) { f32x4 o[2];
#pragma unroll
                        for (int n = 0; n < 2; ++n) { const f32x4 v = acc[ai][bj][m][n] * r + bv[bj][n];
#pragma unroll
                            for (int k = 0; k < 4; ++k) o[n][k] = fmaxf(sigm(v[k]), 1e-18f); }
                        st_nt(rp + bj * HALF, pack8(o[0], o[1])); } }
        }
        return false;
    }
};
struct EpiMix {
    static constexpr bool PERM = true, AFTER_DRAIN = false;
    const bf16_t* gA; const bf16_t* gB; const bf16_t* gC; bf16_t* mixed;
    __device__ __forceinline__ void prefetch(const Unit&, int, int) {}
    __device__ __forceinline__ void stash(int, int) const {}
    __device__ __forceinline__ bool operator()(f32x4 (&acc)[2][2][4][2], const Unit& u, int wr, int wc, int fr, int fq) const {
        const int X = u.pn >> 2, pn = u.pn & 3, pm = u.pm - 768 * X;
        const bf16_t* const pA = gA; const bf16_t* const pB = gB; const bf16_t* const pC = gC;
        const int row0 = pm * BM + wr * 64 + fr, col0 = pn * BM + wc * 32 + 8 * fq;
        if (X < 2) {
            const bf16_t* g1 = pA; const bf16_t* g2 = pB; if (X == 1) { g1 = pB; g2 = pC; }
#pragma unroll
            for (int ai = 0; ai < 2; ++ai) {
                u32x4 nv[4][2], dv[4][2];
#pragma unroll
                for (int m = 0; m < 4; ++m)
#pragma unroll
                    for (int bj = 0; bj < 2; ++bj) { const size_t off = (size_t)(row0 + ai * HALF + m * 16) * D + col0 + bj * HALF; nv[m][bj] = *(const u32x4*)(g1 + off); dv[m][bj] = *(const u32x4*)(g2 + off); }
                asm volatile("" ::: "memory");
#pragma unroll
                for (int m = 0; m < 4; ++m)
#pragma unroll
                    for (int bj = 0; bj < 2; ++bj) { f32x4 n0, n1, d0, d1; unpack8(nv[m][bj], n0, n1); unpack8(dv[m][bj], d0, d1);
#pragma unroll
                        for (int k = 0; k < 4; ++k) { acc[ai][bj][m][0][k] *= n0[k] * rcpf_(d0[k]); acc[ai][bj][m][1][k] *= n1[k] * rcpf_(d1[k]); } }
            }
            return true;
        }
#pragma unroll
        for (int ai = 0; ai < 2; ++ai) {
            u32x4 cv[4][2];
#pragma unroll
            for (int m = 0; m < 4; ++m)
#pragma unroll
                for (int bj = 0; bj < 2; ++bj) cv[m][bj] = *(const u32x4*)(pC + (size_t)(row0 + ai * HALF + m * 16) * D + col0 + bj * HALF);
            asm volatile("" ::: "memory");
#pragma unroll
            for (int m = 0; m < 4; ++m) { const size_t off = (size_t)(row0 + ai * HALF + m * 16) * D + col0;
#pragma unroll
                for (int bj = 0; bj < 2; ++bj) { f32x4 c0, c1; unpack8(cv[m][bj], c0, c1);
                    *(u32x4*)(mixed + off + bj * HALF) = pack8(acc[ai][bj][m][0] * c0, acc[ai][bj][m][1] * c1); } }
            asm volatile("" ::: "memory");
        }
        return false;
    }
};
struct MixOrder {
    StaticOrder base;
    __device__ __forceinline__ bool next(int i, Unit& u) const { const int j = i / 3, X = i - 3 * j; Unit t; if (!base.next(j, t)) return false; u.pm = t.pm + 768 * X; u.pn = t.pn + 4 * X; return true; }
    __device__ __forceinline__ void a_ready(const Unit&) const {}
    __device__ __forceinline__ void done(const Unit&) const {}
};

template <class Epi, class Sched, bool ALIGN_EPI = false, bool SP2 = false>
__device__ __forceinline__ void gemm_phase(PG8_LAS unsigned char* lds, const Gemm g, const Sched& S, Epi& E) {
    int tid_ = threadIdx.x; asm volatile("" : "+v"(tid_));
    const int tid = tid_, wid = __builtin_amdgcn_readfirstlane(tid >> 6), lane = tid & 63, wr = wid >> 2, wc = wid & 3, fr = lane & 15, fq = lane >> 4;
    const int K = g.K, nt = K / BK;
    unsigned voffA[2], voffB[2];
#pragma unroll
    for (int i = 0; i < 2; ++i) { int R, C; stage_rc(tid * 16 + i * 8192, R, C); const int Rb = Epi::PERM ? ((R & ~31) + perm32(R & 31)) : R;
        voffA[i] = (unsigned)(R * K + C) * 2u; voffB[i] = (unsigned)(Rb * K + C) * 2u; }
    const size_t kstep = (size_t)(BK * 2);
    const size_t hstep = (size_t)HALF * K * 2;
    const size_t tstep = 2 * hstep;
    const unsigned ldsw = (unsigned)wid * 1024u;
    const int aoff = lds_byte(wr * 64 + fr, fq * 8), boff = lds_byte(wc * 32 + fr, fq * 8);
#define PG8_SA(b, h) (((b) * 2 + (h)) * HTB)
#define PG8_SB(b, h) ((4 + (b) * 2 + (h)) * HTB)
#define PG8_STAGE(bufoff, gbase, voff) do { _Pragma("unroll") for (int _i = 0; _i < 2; ++_i) \
        __builtin_amdgcn_global_load_lds((const unsigned*)((const char*)(gbase) + (voff)[_i]), (PG8_LAS unsigned*)(lds + (bufoff) + ldsw + _i * 8192), 16, 0, 0); } while (0)
#define PG8_LDA(dst, b, h) do { _Pragma("unroll") for (int m = 0; m < 4; ++m) _Pragma("unroll") for (int k = 0; k < 2; ++k) dst[m][k] = *(const PG8_LAS bf16x8*)(lds + PG8_SA(b, h) + aoff + m * 2048 + k * 1024); } while (0)
#define PG8_LDB(dst, b, h) do { _Pragma("unroll") for (int n = 0; n < 2; ++n) _Pragma("unroll") for (int k = 0; k < 2; ++k) dst[n][k] = *(const PG8_LAS bf16x8*)(lds + PG8_SB(b, h) + boff + n * 2048 + k * 1024); } while (0)
#define PG8_MMA(ai, bj, At, Bt) do { __builtin_amdgcn_s_setprio(1); _Pragma("unroll") for (int m = 0; m < 4; ++m) _Pragma("unroll") for (int n = 0; n < 2; ++n) _Pragma("unroll") for (int k = 0; k < 2; ++k) \
        acc[ai][bj][m][n] = __builtin_amdgcn_mfma_f32_16x16x32_bf16(Bt[n][k], At[m][k], acc[ai][bj][m][n], 0, 0, 0); __builtin_amdgcn_s_setprio(0); } while (0)
#define PG8_WAIT_V(n) asm volatile("s_waitcnt vmcnt(" #n ")" ::: "memory")
#define PG8_WAIT_L(n) asm volatile("s_waitcnt lgkmcnt(" #n ")" ::: "memory")
#define PG8_BAR __builtin_amdgcn_s_barrier()
#define PG8_SCHED __builtin_amdgcn_sched_barrier(0)
    Unit cur, nxt; int ui = 0;
    if (!S.next(0, cur)) return;
    f32x4 acc[2][2][4][2];
#pragma unroll
    for (int a = 0; a < 2; ++a)
#pragma unroll
        for (int b = 0; b < 2; ++b)
#pragma unroll
            for (int m = 0; m < 4; ++m)
#pragma unroll
                for (int n = 0; n < 2; ++n) acc[a][b][m][n] = (f32x4){0.f, 0.f, 0.f, 0.f};
    bf16x8 At[4][2], B0[2][2], B1[2][2];
    const char* cA = (const char*)g.A + (size_t)cur.pm * tstep; const char* cB = (const char*)g.Bt + (size_t)cur.pn * tstep;
    S.a_ready(cur); E.prefetch(cur, wr, lane);
    if constexpr (SP2) {
        PG8_STAGE(PG8_SB(0, 0), cB, voffB); PG8_STAGE(PG8_SB(0, 1), cB + hstep, voffB); PG8_STAGE(PG8_SA(0, 0), cA, voffA); PG8_STAGE(PG8_SA(0, 1), cA + hstep, voffA);
        if (wr == 1) PG8_BAR;
        PG8_WAIT_V(2); PG8_BAR;
        PG8_STAGE(PG8_SB(1, 0), cB + kstep, voffB); PG8_STAGE(PG8_SA(1, 0), cA + kstep, voffA); PG8_STAGE(PG8_SB(1, 1), cB + hstep + kstep, voffB);
        PG8_WAIT_V(6); PG8_BAR;
    } else {
        PG8_STAGE(PG8_SB(0, 0), cB, voffB); PG8_STAGE(PG8_SA(0, 0), cA, voffA); PG8_STAGE(PG8_SB(0, 1), cB + hstep, voffB); PG8_STAGE(PG8_SA(0, 1), cA + hstep, voffA);
        if (wr == 1) PG8_BAR;
        PG8_WAIT_V(4); PG8_BAR;
        PG8_STAGE(PG8_SB(1, 0), cB + kstep, voffB); PG8_STAGE(PG8_SA(1, 0), cA + kstep, voffA); PG8_STAGE(PG8_SB(1, 1), cB + hstep + kstep, voffB);
        PG8_WAIT_V(6); PG8_BAR;
    }
    for (;;) {
        const bool has_next = S.next(ui + 1, nxt);
        const char* nA = has_next ? (const char*)g.A + (size_t)nxt.pm * tstep : cA; const char* nB = has_next ? (const char*)g.Bt + (size_t)nxt.pn * tstep : cB;
        for (int t = 0; t < nt; t += 2) {
            const bool last = (t == nt - 2);
            const char* a1 = cA + (size_t)(t + 1) * kstep;
            const char* a2 = last ? nA : cA + (size_t)(t + 2) * kstep; const char* b2 = last ? nB : cB + (size_t)(t + 2) * kstep;
            const char* a3 = a2 + kstep; const char* b3 = b2 + kstep;
            if (last) { E.stash(wid, lane); if (has_next) { S.a_ready(nxt); E.prefetch(nxt, wr, lane); } }
            if constexpr (SP2) {
            PG8_LDB(B0, 0, 0); PG8_LDB(B1, 0, 1); PG8_SCHED; PG8_LDA(At, 0, 0); PG8_STAGE(PG8_SA(1, 1), a1 + hstep, voffA);
            PG8_WAIT_V(8); PG8_WAIT_L(0); PG8_BAR; PG8_MMA(0, 0, At, B0); PG8_MMA(0, 1, At, B1); PG8_BAR; PG8_SCHED;
            PG8_LDA(At, 0, 1); PG8_STAGE(PG8_SB(0, 0), b2, voffB); PG8_STAGE(PG8_SB(0, 1), b2 + hstep, voffB); PG8_STAGE(PG8_SA(0, 0), a2, voffA);
            PG8_WAIT_V(8); PG8_WAIT_L(0); PG8_BAR; PG8_MMA(1, 0, At, B0); PG8_MMA(1, 1, At, B1); PG8_BAR; PG8_SCHED;
            PG8_LDB(B0, 1, 0); PG8_LDB(B1, 1, 1); PG8_SCHED; PG8_LDA(At, 1, 0); PG8_STAGE(PG8_SA(0, 1), a2 + hstep, voffA);
            PG8_WAIT_V(8); PG8_WAIT_L(0); PG8_BAR; PG8_MMA(0, 0, At, B0); PG8_MMA(0, 1, At, B1); PG8_BAR; PG8_SCHED;
            PG8_LDA(At, 1, 1); PG8_STAGE(PG8_SB(1, 0), b3, voffB); PG8_STAGE(PG8_SB(1, 1), b3 + hstep, voffB); PG8_STAGE(PG8_SA(1, 0), a3, voffA);
            PG8_WAIT_V(8); PG8_WAIT_L(0); PG8_BAR; PG8_MMA(1, 0, At, B0); PG8_MMA(1, 1, At, B1); PG8_BAR; PG8_SCHED;
            } else {
            PG8_LDB(B0, 0, 0); PG8_SCHED; PG8_LDA(At, 0, 0); PG8_STAGE(PG8_SA(1, 1), a1 + hstep, voffA);
            PG8_WAIT_L(8); PG8_BAR; PG8_WAIT_L(0); PG8_MMA(0, 0, At, B0); PG8_BAR; PG8_SCHED;
            PG8_LDB(B1, 0, 1); PG8_STAGE(PG8_SB(0, 0), b2, voffB);
            PG8_BAR; PG8_WAIT_L(0); PG8_MMA(0, 1, At, B1); PG8_BAR;
            PG8_LDA(At, 0, 1); PG8_STAGE(PG8_SA(0, 0), a2, voffA);
            PG8_BAR; PG8_WAIT_L(0); PG8_MMA(1, 0, At, B0); PG8_BAR; PG8_SCHED;
            PG8_STAGE(PG8_SB(0, 1), b2 + hstep, voffB);
            PG8_WAIT_V(6); PG8_BAR; PG8_MMA(1, 1, At, B1); PG8_BAR;
            PG8_LDB(B0, 1, 0); PG8_SCHED; PG8_LDA(At, 1, 0); PG8_STAGE(PG8_SA(0, 1), a2 + hstep, voffA);
            PG8_WAIT_L(8); PG8_BAR; PG8_WAIT_L(0); PG8_MMA(0, 0, At, B0); PG8_BAR; PG8_SCHED;
            PG8_LDB(B1, 1, 1); PG8_STAGE(PG8_SB(1, 0), b3, voffB);
            PG8_BAR; PG8_WAIT_L(0); PG8_MMA(0, 1, At, B1); PG8_BAR;
            PG8_LDA(At, 1, 1); PG8_STAGE(PG8_SA(1, 0), a3, voffA);
            PG8_BAR; PG8_WAIT_L(0); PG8_MMA(1, 0, At, B0); PG8_BAR; PG8_SCHED;
            PG8_STAGE(PG8_SB(1, 1), b3 + hstep, voffB);
            PG8_WAIT_V(6); PG8_BAR; PG8_MMA(1, 1, At, B1); PG8_BAR;
            }
        }
        if constexpr (ALIGN_EPI) { if (wr == 0) PG8_BAR; }
        bool keep = false;
        if constexpr (!Epi::AFTER_DRAIN) { keep = E(acc, cur, wr, wc, fr, fq); S.done(cur); }
        if (!has_next) break;
        if (!keep) {
#pragma unroll
        for (int a = 0; a < 2; ++a)
#pragma unroll
            for (int b = 0; b < 2; ++b)
#pragma unroll
                for (int m = 0; m < 4; ++m)
#pragma unroll
                    for (int n = 0; n < 2; ++n) acc[a][b][m][n] = (f32x4){0.f, 0.f, 0.f, 0.f};
        }
        cur = nxt; cA = nA; cB = nB; ++ui;
        if constexpr (ALIGN_EPI) { if (wr == 1) PG8_BAR; }
    }
    PG8_WAIT_V(0);
    if constexpr (!ALIGN_EPI) { if (wr == 0) PG8_BAR; }
    PG8_BAR;
    if constexpr (Epi::AFTER_DRAIN) { E.fused(acc, cur, wr, wc, fr, fq, lds, wid, lane); S.done(cur); }
#undef PG8_SA
#undef PG8_SB
#undef PG8_STAGE
#undef PG8_LDA
#undef PG8_LDB
#undef PG8_MMA
#undef PG8_WAIT_V
#undef PG8_WAIT_L
#undef PG8_BAR
#undef PG8_SCHED
}
}

namespace att {
#define LAS3 __attribute__((address_space(3)))
typedef unsigned short bf16_t;
typedef short bf16x8 __attribute__((ext_vector_type(8)));
typedef short s16x4 __attribute__((ext_vector_type(4)));
typedef float f32x16 __attribute__((ext_vector_type(16)));
typedef float f32x4 __attribute__((ext_vector_type(4)));
typedef unsigned u32x4 __attribute__((ext_vector_type(4)));
constexpr int SLOTB = 8192;
constexpr int L_WS = 0, L_KM = 2048, L_KMX = L_KM + 16384, L_FLG = L_KMX + 64, L_RING = 19456, L_K = L_RING, L_V4 = L_RING + 4 * SLOTB, L_OST = L_RING + 8 * SLOTB, L_K3 = L_RING, L_V3 = L_RING + 6 * SLOTB, L_RED = L_RING, L_END = L_RING + 12 * SLOTB;
static_assert(L_FLG + 64 <= L_RING && L_END <= 131072 && L_OST + 8 * 4096 <= L_END, "mixer LDS map");
constexpr float SB_EXIT = 40.f;
constexpr int L_CONV = 0;
__device__ __forceinline__ int crow(int r, int hi) { return (r & 3) + 8 * (r >> 2) + 4 * hi; }
__device__ __forceinline__ float ex2(float x) { return __builtin_amdgcn_exp2f(x); }
__device__ __forceinline__ float min80(float x) { return __builtin_amdgcn_fmed3f(x, 80.f, -INFINITY); }
__device__ __forceinline__ float lg2(float x) { return __builtin_amdgcn_logf(x); }
__device__ __forceinline__ unsigned cvtpk(float lo, float hi) { unsigned r; asm volatile("v_cvt_pk_bf16_f32 %0, %1, %2" : "=v"(r) : "v"(lo), "v"(hi)); return r; }
__device__ __forceinline__ float bf2f(bf16_t v) { return __uint_as_float((unsigned)v << 16); }
__device__ __forceinline__ void glds16(const void* gsrc, unsigned lds_dst) { unsigned keep;
    asm volatile("s_mov_b32 %0, m0\n\ts_mov_b32 m0, %2\n\ts_nop 0\n\tglobal_load_lds_dwordx4 %1, off\n\ts_mov_b32 m0, %0" : "=&s"(keep) : "v"(gsrc), "s"(lds_dst) : "memory"); }
__device__ __forceinline__ void glds16s(const void* sbase, unsigned voff, unsigned lds_dst) { unsigned keep;
    asm volatile("s_mov_b32 %0, m0\n\ts_mov_b32 m0, %3\n\ts_nop 0\n\tglobal_load_lds_dwordx4 %1, %2\n\ts_mov_b32 m0, %0" : "=&s"(keep) : "v"(voff), "s"(sbase), "s"(lds_dst) : "memory"); }
__device__ __forceinline__ const void* uni_ptr(const void* p) { const unsigned long long a = (unsigned long long)(uintptr_t)p;
    const unsigned lo = (unsigned)__builtin_amdgcn_readfirstlane((int)(unsigned)a), hi = (unsigned)__builtin_amdgcn_readfirstlane((int)(unsigned)(a >> 32)); return (const void*)(uintptr_t)(((unsigned long long)hi << 32) | lo); }
#define ATT_WAIT_BAR() asm volatile("s_waitcnt vmcnt(0) lgkmcnt(0)\n\ts_barrier" ::: "memory")
__device__ __forceinline__ void qkt(f32x16& p0, f32x16& p1, const LAS3 unsigned char* Kslot, const bf16x8* qr, const f32x16& cin, int r32, int hi) {
    const LAS3 unsigned char* kb = Kslot + r32 * 128; const int sw = (r32 >> 1) & 7;
#pragma unroll
    for (int d0 = 0; d0 < 4; ++d0) {
        const int ko = ((2 * d0 + hi) ^ sw) << 4;
        const bf16x8 b0 = *(const LAS3 bf16x8*)(kb + ko);
        const bf16x8 b1 = *(const LAS3 bf16x8*)(kb + ko + 4096);
        if (d0 == 0) { p0 = __builtin_amdgcn_mfma_f32_32x32x16_bf16(b0, qr[0], cin, 0, 0, 0); p1 = __builtin_amdgcn_mfma_f32_32x32x16_bf16(b1, qr[0], cin, 0, 0, 0); }
        else { p0 = __builtin_amdgcn_mfma_f32_32x32x16_bf16(b0, qr[d0], p0, 0, 0, 0); p1 = __builtin_amdgcn_mfma_f32_32x32x16_bf16(b1, qr[d0], p1, 0, 0, 0); } }
}
__device__ __forceinline__ void pv(f32x16* o, int vb, bf16x8 pa0, bf16x8 pa1, bf16x8 pa2, bf16x8 pa3) {
#pragma unroll
    for (int d0 = 0; d0 < 2; ++d0) { s16x4 lo[4], hi[4];
#pragma unroll
        for (int ks = 0; ks < 4; ++ks) {
            asm volatile("ds_read_b64_tr_b16 %0,%1 offset:%c2" : "=&v"(lo[ks]) : "v"(vb), "i"(d0 * 4096 + ks * 1024) : "memory");
            asm volatile("ds_read_b64_tr_b16 %0,%1 offset:%c2" : "=&v"(hi[ks]) : "v"(vb), "i"(d0 * 4096 + ks * 1024 + 512) : "memory"); }
        asm volatile("s_waitcnt lgkmcnt(0)" ::: "memory"); __builtin_amdgcn_sched_barrier(0);
#define ATT_PK(k) (bf16x8){lo[k][0], lo[k][1], lo[k][2], lo[k][3], hi[k][0], hi[k][1], hi[k][2], hi[k][3]}
        o[d0] = __builtin_amdgcn_mfma_f32_32x32x16_bf16(pa0, ATT_PK(0), o[d0], 0, 0, 0);
        o[d0] = __builtin_amdgcn_mfma_f32_32x32x16_bf16(pa1, ATT_PK(1), o[d0], 0, 0, 0);
        o[d0] = __builtin_amdgcn_mfma_f32_32x32x16_bf16(pa2, ATT_PK(2), o[d0], 0, 0, 0);
        o[d0] = __builtin_amdgcn_mfma_f32_32x32x16_bf16(pa3, ATT_PK(3), o[d0], 0, 0, 0);
#undef ATT_PK
    }
}
__device__ __forceinline__ unsigned cvtpk_nv(float lo, float hi) { unsigned r; asm("v_cvt_pk_bf16_f32 %0, %1, %2" : "=v"(r) : "v"(lo), "v"(hi)); return r; }
__device__ __forceinline__ bf16x8 pack8n(const f32x16& p, int b) { u32x4 w; w.x = cvtpk_nv(p[b], p[b + 1]); w.y = cvtpk_nv(p[b + 2], p[b + 3]); w.z = cvtpk_nv(p[b + 4], p[b + 5]); w.w = cvtpk_nv(p[b + 6], p[b + 7]); return __builtin_bit_cast(bf16x8, w); }
__device__ __forceinline__ bf16x8 pack8(const f32x16& p, int b) { u32x4 w; w.x = cvtpk(p[b], p[b + 1]); w.y = cvtpk(p[b + 2], p[b + 3]); w.z = cvtpk(p[b + 4], p[b + 5]); w.w = cvtpk(p[b + 6], p[b + 7]); return __builtin_bit_cast(bf16x8, w); }
__device__ __forceinline__ void store_o(const f32x16* o, const float* rli, bf16_t* Ow, LAS3 unsigned char* shm, int ost, int wid, int lane, int r32, int hi) {
    LAS3 bf16_t* stg = (LAS3 bf16_t*)(shm + ost) + wid * 2048;
#pragma unroll
    for (int r = 0; r < 16; ++r) { const int orow = crow(r, hi);
#pragma unroll
        for (int d0 = 0; d0 < 2; ++d0) stg[orow * 64 + d0 * 32 + r32] = (bf16_t)(cvtpk(o[d0][r] * rli[r], 0.f) & 0xffffu); }
    asm volatile("s_waitcnt lgkmcnt(0)" ::: "memory");
#pragma unroll
    for (int i = 0; i < 4; ++i) { const int row = i * 8 + (lane >> 3), ch = lane & 7; const u32x4 v = *(const LAS3 u32x4*)(stg + row * 64 + ch * 8); *(u32x4*)(Ow + (size_t)row * AW + ch * 8) = v; }
}

__device__ __forceinline__ void sb_units(int b, int h, const bf16_t* Q, const bf16_t* __restrict__ K, const bf16_t* __restrict__ V, bf16_t* O, LAS3 unsigned char* shm) {
    int tid_ = threadIdx.x; asm volatile("" : "+v"(tid_)); const int tid = tid_, lane = tid & 63, r32 = lane & 31, hi = lane >> 5; const int wid = __builtin_amdgcn_readfirstlane(tid >> 6);
    const size_t rowbase = (size_t)b * S;
    const bf16_t* Kh = K + rowbase * AW + h * HD; const bf16_t* Vh = V + rowbase * AW + h * HD;
    const unsigned lds0 = (unsigned)(uintptr_t)shm;
    const int krow = 8 * wid + (lane >> 3); const bf16_t* ksrc = Kh + (size_t)krow * AW + (((lane & 7) ^ ((krow >> 1) & 7)) * 8);
    const bf16_t* vsrc = Vh + (size_t)(16 * (wid & 3) + (lane >> 2)) * AW + (wid >> 2) * 32 + (lane & 3) * 8;
    const unsigned kdst = lds0 + L_K + wid * 1024, vdst = lds0 + L_V4 + wid * 1024;
    const int vb0 = (int)(lds0 + L_V4) + ((lane >> 4) & 1) * 32 + (lane & 3) * 8 + (4 * hi + ((lane & 15) >> 2)) * 64;
#define SB_DMA(t, slot) do { glds16(ksrc + (size_t)(t) * 64 * AW, (unsigned)__builtin_amdgcn_readfirstlane(kdst + (slot) * SLOTB)); glds16(vsrc + (size_t)(t) * 64 * AW, (unsigned)__builtin_amdgcn_readfirstlane(vdst + (slot) * SLOTB)); } while (0)
#pragma unroll
    for (int pre = 0; pre < 3; ++pre) SB_DMA(3 - pre, pre);
    bf16x8 qr[4];
#pragma unroll
    for (int d0 = 0; d0 < 4; ++d0) qr[d0] = *(const bf16x8*)(Q + (rowbase + wid * 32 + r32) * AW + h * HD + d0 * 16 + hi * 8);
    bf16x8 TA0, TA1, ONES;
#pragma unroll
    for (int j = 0; j < 8; ++j) { const int kk = (j & 3) + 8 * (j >> 2) + 4 * hi; TA0[j] = (kk > r32) ? (short)0xBF80 : (short)0; TA1[j] = (kk + 16 > r32) ? (short)0xBF80 : (short)0; ONES[j] = (short)0xBF80; }
    const f32x16 zero16 = f32x16{};
    const int qrel = wid * 32 + r32;
    if (wid >= 4) __builtin_amdgcn_s_setprio(1);
  for (int qb = 0; qb < 8; ++qb) {
    const int q0 = qb * 256, NT = 4 * qb + 4;
    f32x16 o[2]; o[0] = f32x16{}; o[1] = f32x16{};
    float C = 0.f;
    volatile LAS3 unsigned* flg = (volatile LAS3 unsigned*)(shm + L_FLG);
    bool wdone = false;
    for (int it = 0; it < NT; ++it) {
        const int t = NT - 1 - it, slot = it & 3;
        { const int younger = (NT - 1 - it < 2 ? NT - 1 - it : 2);
          if (younger == 2) asm volatile("s_waitcnt vmcnt(4) lgkmcnt(0)\n\ts_barrier" ::: "memory");
          else if (younger == 1) asm volatile("s_waitcnt vmcnt(2) lgkmcnt(0)\n\ts_barrier" ::: "memory");
          else ATT_WAIT_BAR(); }
        if (it > 0) { volatile LAS3 unsigned* f = flg + ((it - 1) & 1) * 8; unsigned all = f[0] & f[1] & f[2] & f[3] & f[4] & f[5] & f[6] & f[7]; if (__builtin_amdgcn_readfirstlane(all)) break; }
        if (it + 3 < NT) SB_DMA(t - 3, (it + 3) & 3);
        const int jb = t - 4 * qb;
        const bool active = !wdone && ((jb < 0) || (64 * jb < 32 * wid + 31));
        if (active) {
            f32x16 p0, p1, s0, s1;
            qkt(p0, p1, shm + L_K + slot * SLOTB, qr, zero16, r32, hi);
#pragma unroll
            for (int r = 0; r < 16; ++r) { p0[r] = min80(p0[r]); p1[r] = min80(p1[r]); s0[r] = lg2(1.f + ex2(p0[r])); s1[r] = lg2(1.f + ex2(p1[r])); }
            if (jb >= 0) {
#pragma unroll
                for (int r = 0; r < 16; ++r) { const int kv = 64 * jb + crow(r, hi);
                    if (kv >= qrel) { s0[r] = 0.f; p0[r] = -INFINITY; } if (kv + 32 >= qrel) { s1[r] = 0.f; p1[r] = -INFINITY; } }
            }
            const bf16x8 B0 = pack8(s0, 0), B1 = pack8(s0, 8), B2 = pack8(s1, 0), B3 = pack8(s1, 8);
            f32x16 cin;
#pragma unroll
            for (int r = 0; r < 16; ++r) cin[r] = C;
            f32x16 x0 = __builtin_amdgcn_mfma_f32_32x32x16_bf16(TA0, B0, cin, 0, 0, 0);
            x0 = __builtin_amdgcn_mfma_f32_32x32x16_bf16(TA1, B1, x0, 0, 0, 0);
            x0 = __builtin_amdgcn_mfma_f32_32x32x16_bf16(ONES, B2, x0, 0, 0, 0);
            x0 = __builtin_amdgcn_mfma_f32_32x32x16_bf16(ONES, B3, x0, 0, 0, 0);
            f32x16 x1 = __builtin_amdgcn_mfma_f32_32x32x16_bf16(TA0, B2, cin, 0, 0, 0);
            x1 = __builtin_amdgcn_mfma_f32_32x32x16_bf16(TA1, B3, x1, 0, 0, 0);
            const float cnew = x0[0] - s0[0];
            C = __shfl(cnew, r32);
#pragma unroll
            for (int r = 0; r < 16; ++r) { p0[r] = ex2(p0[r] - s0[r] + x0[r]); p1[r] = ex2(p1[r] - s1[r] + x1[r]); }
            pv(o, vb0 + slot * SLOTB, pack8(p0, 0), pack8(p0, 8), pack8(p1, 0), pack8(p1, 8));
        }
        { const bool done = __builtin_amdgcn_ballot_w64(C > -SB_EXIT) == 0ull; wdone = done; if (lane == 0) flg[(it & 1) * 8 + wid] = done ? 1u : 0u; }
    }
    ATT_WAIT_BAR();
    bf16x8 qn[4];
    if (qb < 7) {
#pragma unroll
        for (int pre = 0; pre < 3; ++pre) SB_DMA(NT + 3 - pre, pre);
#pragma unroll
        for (int d0 = 0; d0 < 4; ++d0) qn[d0] = *(const bf16x8*)(Q + (rowbase + q0 + 256 + wid * 32 + r32) * AW + h * HD + d0 * 16 + hi * 8);
    }
    float rli[16];
#pragma unroll
    for (int r = 0; r < 16; ++r) rli[r] = 1.f;
    store_o(o, rli, O + (rowbase + q0 + wid * 32) * AW + h * HD, shm, L_OST, wid, lane, r32, hi);
    if (qb < 7) {
#pragma unroll
        for (int d0 = 0; d0 < 4; ++d0) qr[d0] = qn[d0]; }
  }
    __builtin_amdgcn_s_setprio(0);
    ATT_WAIT_BAR();
#undef SB_DMA
}

constexpr float MB_EXIT = 51.f, MB_REF = 45.f;
__device__ __forceinline__ void moba_units(int b, int jdeal, const bf16_t* Q, const bf16_t* __restrict__ K, const bf16_t* __restrict__ V, bf16_t* O, LAS3 unsigned char* shm) {
    int tid_ = threadIdx.x; asm volatile("" : "+v"(tid_)); const int tid = tid_, lane = tid & 63, r32 = lane & 31, hi = lane >> 5; const int wid = __builtin_amdgcn_readfirstlane(tid >> 6);
    const size_t rowbase = (size_t)b * S;
    const unsigned lds0 = (unsigned)(uintptr_t)shm;
    const int krow = 8 * wid + (lane >> 3);
    const bf16_t* ksrc0 = K + rowbase * AW; const bf16_t* vsrc0 = V + rowbase * AW;
    const unsigned koff = (unsigned)(krow * AW + (((lane & 7) ^ ((krow >> 1) & 7)) * 8)) * 2u;
    const unsigned voff = (unsigned)((16 * (wid & 3) + (lane >> 2)) * AW + (wid >> 2) * 32 + (lane & 3) * 8) * 2u;
    const unsigned kdst = lds0 + L_K3 + wid * 1024, vdst = lds0 + L_V3 + wid * 1024;
    const int vb0 = (int)(lds0 + L_V3) + ((lane >> 4) & 1) * 32 + (lane & 3) * 8 + (4 * hi + ((lane & 15) >> 2)) * 64;
#define MB_DMA2(ksrc, vsrc, dt, slot) do { const void* kb_ = uni_ptr(ksrc + (size_t)(2 * (dt)) * 64 * AW); const void* vb_ = uni_ptr(vsrc + (size_t)(2 * (dt)) * 64 * AW); \
        glds16s(kb_, koff, (unsigned)__builtin_amdgcn_readfirstlane(kdst + (slot) * 2 * SLOTB)); glds16s(kb_, koff + 64 * AW * 2, (unsigned)__builtin_amdgcn_readfirstlane(kdst + (slot) * 2 * SLOTB + SLOTB)); \
        glds16s(vb_, voff, (unsigned)__builtin_amdgcn_readfirstlane(vdst + (slot) * 2 * SLOTB)); glds16s(vb_, voff + 64 * AW * 2, (unsigned)__builtin_amdgcn_readfirstlane(vdst + (slot) * 2 * SLOTB + SLOTB)); } while (0)
#define MB_OWN(i) ((i) < 4 ? (((i) & 1) ? ((jdeal + 2 * ((i) >> 1) + 2) & 7) : 7 - ((jdeal + 2 * ((i) >> 1) + 2) & 7)) : (((i) & 1) ? 7 - jdeal : jdeal))
#define MB_ASC(i) ((i) >= 4 && !((i) & 1))
    bf16x8 qr[4];
    const unsigned qoff = (unsigned)(r32 * AW + hi * 8) * 2u;
    { const int own0 = MB_OWN(0); MB_DMA2(ksrc0, vsrc0, 2 * own0 + 1, 0);
#pragma unroll
      for (int d0 = 0; d0 < 4; ++d0) qr[d0] = *(const bf16x8*)((const char*)(Q + (rowbase + own0 * 256 + wid * 32) * AW) + qoff + d0 * 32); }
    bf16x8 ONESA;
#pragma unroll
    for (int j = 0; j < 8; ++j) ONESA[j] = (short)0x3F80;
    if (wid >= 4) __builtin_amdgcn_s_setprio(1);
  for (int h = 0; h < 8; ++h) {
    const int own = MB_OWN(h), q0 = own * 256, ND = 2 * own + 2; const bool asc = MB_ASC(h);
#define ksrc (ksrc0 + h * HD)
#define vsrc (vsrc0 + h * HD)
    unsigned sel = 0u; float qn;
    {
        const LAS3 float* km = (const LAS3 float*)(shm + L_KM) + h * 512;
        float gsc[8]; float q2 = 0.f;
#pragma unroll
        for (int d0 = 0; d0 < 4; ++d0)
#pragma unroll
            for (int j = 0; j < 8; ++j) { const float qv = bf2f((bf16_t)qr[d0][j]); q2 += qv * qv; }
        q2 += __shfl_xor(q2, 32); qn = __builtin_sqrtf(q2) * 1.0001f;
#pragma unroll
        for (int pb = 0; pb < 8; ++pb) { float s = 0.f;
#pragma unroll
            for (int d0 = 0; d0 < 4; ++d0)
#pragma unroll
                for (int j = 0; j < 8; ++j) s += bf2f((bf16_t)qr[d0][j]) * km[pb * 64 + d0 * 16 + hi * 8 + j];
            s += __shfl_xor(s, 32);
            gsc[pb] = pb < own ? s : -INFINITY; }
#pragma unroll
        for (int it = 0; it < 3; ++it) { int best = -1; float bv = -INFINITY;
#pragma unroll
            for (int pb = 0; pb < 8; ++pb) { const bool c = !((sel >> pb) & 1u) && gsc[pb] > bv; bv = c ? gsc[pb] : bv; best = c ? pb : best; }
            if (best >= 0) sel |= 1u << best; }
    }
    const float kmax = ((const LAS3 float*)(shm + L_KMX))[h];
    const float slope2 = exp2f(-(float)(h + 1)) * LOG2E;
    const float d32 = 32.f * slope2, d64 = 64.f * slope2, d96 = 96.f * slope2;
    f32x16 o[2]; o[0] = f32x16{}; o[1] = f32x16{};
    float mrun = -1e30f, lrun = 0.f;
    f32x16 lvec = f32x16{};
    const float Bq = qn * kmax;
    const bool fast = __builtin_amdgcn_ballot_w64(!(Bq <= MB_REF)) == 0ull;
    LAS3 float* wsf = (LAS3 float*)(shm + L_WS) + wid * 64;
    volatile LAS3 unsigned* flg = (volatile LAS3 unsigned*)(shm + L_FLG);
    const int qrel = wid * 32 + r32;
    bool wdone = false; int s3 = 0;
    MB_DMA2(ksrc, vsrc, asc ? 1 : ND - 2, 1);
    if (fast) {
    for (int it = 0; it < ND; ++it) {
        const int dt = asc ? it : ND - 1 - it, slot = s3;
        if (it + 1 < ND) asm volatile("s_waitcnt vmcnt(4) lgkmcnt(0)\n\ts_barrier" ::: "memory");
        else ATT_WAIT_BAR();
        if (it > 0) { volatile LAS3 unsigned* f = flg + ((it - 1) & 1) * 8; unsigned all = f[0] & f[1] & f[2] & f[3] & f[4] & f[5] & f[6] & f[7]; if (__builtin_amdgcn_readfirstlane(all)) break; }
        if (it + 2 < ND) MB_DMA2(ksrc, vsrc, asc ? dt + 2 : dt - 2, (s3 == 0 ? 2 : s3 - 1));
        s3 = (s3 == 2) ? 0 : s3 + 1;
        const int pb = dt >> 1, jb = dt - 2 * own;
        const bool selme = (jb >= 0) || ((sel >> pb) & 1u);
        const bool active = !wdone && ((jb >= 0) ? (128 * jb <= 32 * wid + 31) : (__builtin_amdgcn_ballot_w64(selme) != 0ull));
        if (active && true) {
            const int istar = (jb >= 0) ? wid - 4 * jb : 4;
            const float basev = slope2 * (float)(128 * dt + 4 * hi - (q0 + qrel)) - Bq;
            const int kb = (int)(lds0 + L_K3) + slot * 2 * SLOTB + r32 * 128; const int ksw = (r32 >> 1) & 7;
            const int kbd[4] = {kb + (((0 + hi) ^ ksw) << 4), kb + (((2 + hi) ^ ksw) << 4), kb + (((4 + hi) ^ ksw) << 4), kb + (((6 + hi) ^ ksw) << 4)};
#define MB_KREAD(F, D0, OFF) asm volatile("ds_read_b128 %0,%1 offset:%c2" : "=&v"(F) : "v"(kbd[D0]), "i"(OFF) : "memory")
            bf16x8 fa[8], fb[8];
#pragma unroll
            for (int d0 = 0; d0 < 4; ++d0) { MB_KREAD(fa[2 * d0], d0, 0); MB_KREAD(fa[2 * d0 + 1], d0, 4096); }
            f32x16 p0, p1, p2, p3;
#define MB_CIN(P, I) do { const float bi_ = (selme && (I) <= istar) ? basev + (float)(I) * d32 : -INFINITY; \
                _Pragma("unroll") for (int r = 0; r < 16; ++r) P[r] = __builtin_fmaf(slope2, (float)((r & 3) + 8 * (r >> 2)), bi_); \
                if ((I) == istar) { _Pragma("unroll") for (int r = 0; r < 16; ++r) if (crow(r, hi) > r32) P[r] = -INFINITY; } } while (0)
            MB_CIN(p0, 0); MB_CIN(p1, 1); MB_CIN(p2, 2); MB_CIN(p3, 3);
#undef MB_CIN
            asm volatile("s_waitcnt lgkmcnt(0)" ::: "memory"); __builtin_amdgcn_sched_barrier(0);
#pragma unroll
            for (int d0 = 0; d0 < 4; ++d0) { MB_KREAD(fb[2 * d0], d0, SLOTB); MB_KREAD(fb[2 * d0 + 1], d0, SLOTB + 4096); }
            __builtin_amdgcn_sched_barrier(0);
#pragma unroll
            for (int d0 = 0; d0 < 4; ++d0) { p0 = __builtin_amdgcn_mfma_f32_32x32x16_bf16(fa[2 * d0], qr[d0], p0, 0, 0, 0); p1 = __builtin_amdgcn_mfma_f32_32x32x16_bf16(fa[2 * d0 + 1], qr[d0], p1, 0, 0, 0); }
            const int vb = vb0 + slot * 2 * SLOTB;
            s16x4 vlo[4], vhi[4], wlo[4], whi[4];
#define MB_VREADS(LO, HI, VB, D0) do { _Pragma("unroll") for (int ks = 0; ks < 4; ++ks) { \
                asm volatile("ds_read_b64_tr_b16 %0,%1 offset:%c2" : "=&v"(LO[ks]) : "v"(VB), "i"((D0) * 4096 + ks * 1024) : "memory"); \
                asm volatile("ds_read_b64_tr_b16 %0,%1 offset:%c2" : "=&v"(HI[ks]) : "v"(VB), "i"((D0) * 4096 + ks * 1024 + 512) : "memory"); } } while (0)
#define MB_LSUM(PA0, PA1, PA2, PA3) do { lvec = __builtin_amdgcn_mfma_f32_32x32x16_bf16(ONESA, PA0, lvec, 0, 0, 0); lvec = __builtin_amdgcn_mfma_f32_32x32x16_bf16(ONESA, PA1, lvec, 0, 0, 0); \
                lvec = __builtin_amdgcn_mfma_f32_32x32x16_bf16(ONESA, PA2, lvec, 0, 0, 0); lvec = __builtin_amdgcn_mfma_f32_32x32x16_bf16(ONESA, PA3, lvec, 0, 0, 0); } while (0)
#define MB_PK(LO, HI, k) (bf16x8){LO[k][0], LO[k][1], LO[k][2], LO[k][3], HI[k][0], HI[k][1], HI[k][2], HI[k][3]}
#define MB_PV(D0, LO, HI, PA0, PA1, PA2, PA3) do { \
                o[D0] = __builtin_amdgcn_mfma_f32_32x32x16_bf16(PA0, MB_PK(LO, HI, 0), o[D0], 0, 0, 0); o[D0] = __builtin_amdgcn_mfma_f32_32x32x16_bf16(PA1, MB_PK(LO, HI, 1), o[D0], 0, 0, 0); \
                o[D0] = __builtin_amdgcn_mfma_f32_32x32x16_bf16(PA2, MB_PK(LO, HI, 2), o[D0], 0, 0, 0); o[D0] = __builtin_amdgcn_mfma_f32_32x32x16_bf16(PA3, MB_PK(LO, HI, 3), o[D0], 0, 0, 0); } while (0)
            asm volatile("s_waitcnt lgkmcnt(0)" ::: "memory");
            MB_VREADS(vlo, vhi, vb, 0);
            __builtin_amdgcn_sched_barrier(0);
#pragma unroll
            for (int d0 = 0; d0 < 4; ++d0) { p2 = __builtin_amdgcn_mfma_f32_32x32x16_bf16(fb[2 * d0], qr[d0], p2, 0, 0, 0); p3 = __builtin_amdgcn_mfma_f32_32x32x16_bf16(fb[2 * d0 + 1], qr[d0], p3, 0, 0, 0); }
#pragma unroll
            for (int r = 0; r < 16; ++r) { p0[r] = ex2(p0[r]); p1[r] = ex2(p1[r]); }
            const bf16x8 a0 = pack8n(p0, 0), a1 = pack8n(p0, 8), a2 = pack8n(p1, 0), a3 = pack8n(p1, 8);
            __builtin_amdgcn_sched_barrier(0);
            asm volatile("s_waitcnt lgkmcnt(0)" ::: "memory");
            MB_VREADS(wlo, whi, vb, 1);
            __builtin_amdgcn_sched_barrier(0);
            MB_PV(0, vlo, vhi, a0, a1, a2, a3);
#pragma unroll
            for (int r = 0; r < 16; ++r) p2[r] = ex2(p2[r]);
            __builtin_amdgcn_sched_barrier(0);
            asm volatile("s_waitcnt lgkmcnt(0)" ::: "memory");
            MB_VREADS(vlo, vhi, vb + SLOTB, 0);
            __builtin_amdgcn_sched_barrier(0);
            MB_PV(1, wlo, whi, a0, a1, a2, a3);
            MB_LSUM(a0, a1, a2, a3);
#pragma unroll
            for (int r = 0; r < 16; ++r) p3[r] = ex2(p3[r]);
            const bf16x8 b0 = pack8n(p2, 0), b1 = pack8n(p2, 8), b2 = pack8n(p3, 0), b3 = pack8n(p3, 8);
            __builtin_amdgcn_sched_barrier(0);
            asm volatile("s_waitcnt lgkmcnt(0)" ::: "memory");
            MB_VREADS(wlo, whi, vb + SLOTB, 1);
            __builtin_amdgcn_sched_barrier(0);
            MB_PV(0, vlo, vhi, b0, b1, b2, b3);
            __builtin_amdgcn_sched_barrier(0);
            asm volatile("s_waitcnt lgkmcnt(0)" ::: "memory");
            __builtin_amdgcn_sched_barrier(0);
            MB_PV(1, wlo, whi, b0, b1, b2, b3);
            MB_LSUM(b0, b1, b2, b3);
#undef MB_PV
#undef MB_LSUM
#undef MB_PK
#undef MB_VREADS
#undef MB_KREAD
            mrun = Bq + lg2(lvec[0]);
        } else if (active) {
            f32x16 p0, p1, p2, p3, cin;
            const float base = selme ? slope2 * (float)(128 * dt + 4 * hi - (q0 + qrel)) : -INFINITY;
#pragma unroll
            for (int r = 0; r < 16; ++r) cin[r] = __builtin_fmaf(slope2, (float)((r & 3) + 8 * (r >> 2)), base);
            qkt(p0, p1, shm + L_K3 + slot * 2 * SLOTB, qr, cin, r32, hi);
            qkt(p2, p3, shm + L_K3 + slot * 2 * SLOTB + SLOTB, qr, cin, r32, hi);
            if (jb >= 0) {
#pragma unroll
                for (int r = 0; r < 16; ++r) { const int kv = 128 * jb + crow(r, hi);
                    if (kv > qrel) p0[r] = -INFINITY; if (kv + 32 > qrel) p1[r] = -INFINITY; if (kv + 64 > qrel) p2[r] = -INFINITY; if (kv + 96 > qrel) p3[r] = -INFINITY; }
            }
            float rm0 = p0[0], rm1 = p1[0], rm2 = p2[0], rm3 = p3[0];
#pragma unroll
            for (int r = 1; r < 16; ++r) { rm0 = fmaxf(rm0, p0[r]); rm1 = fmaxf(rm1, p1[r]); rm2 = fmaxf(rm2, p2[r]); rm3 = fmaxf(rm3, p3[r]); }
            float rm = fmaxf(fmaxf(rm0, rm1 + d32), fmaxf(rm2 + d64, rm3 + d96));
            rm = fmaxf(rm, __shfl_xor(rm, 32));
            const float mn = fmaxf(mrun, rm);
            if (__builtin_amdgcn_ballot_w64(mn > mrun) != 0ull) {
                const float alpha = ex2(mrun - mn); lrun *= alpha;
                if (hi == 0) wsf[r32] = alpha;
                asm volatile("s_waitcnt lgkmcnt(0)" ::: "memory");
#pragma unroll
                for (int r = 0; r < 16; ++r) { const float a = wsf[crow(r, hi)]; o[0][r] *= a; o[1][r] *= a; }
            }
            mrun = mn;
            const float mn1 = mn - d32, mn2 = mn - d64, mn3 = mn - d96; float sum = 0.f;
#pragma unroll
            for (int r = 0; r < 16; ++r) { p0[r] = ex2(p0[r] - mn); p1[r] = ex2(p1[r] - mn1); p2[r] = ex2(p2[r] - mn2); p3[r] = ex2(p3[r] - mn3); sum += (p0[r] + p1[r]) + (p2[r] + p3[r]); }
            lrun += sum;
            pv(o, vb0 + slot * 2 * SLOTB, pack8(p0, 0), pack8(p0, 8), pack8(p1, 0), pack8(p1, 8));
            pv(o, vb0 + slot * 2 * SLOTB + SLOTB, pack8(p2, 0), pack8(p2, 8), pack8(p3, 0), pack8(p3, 8));
        }
        { const float ub = slope2 * (float)(128 * (dt - 1) + 127 - (q0 + qrel)) + qn * kmax;
          const bool done = !asc && (dt <= 2 * own) && (__builtin_amdgcn_ballot_w64(!(ub < mrun - MB_EXIT)) == 0ull); wdone = done; if (lane == 0) flg[(it & 1) * 8 + wid] = done ? 1u : 0u; }
    }
    } else {
    for (int it = 0; it < ND; ++it) {
        const int dt = asc ? it : ND - 1 - it, slot = s3;
        if (it + 1 < ND) asm volatile("s_waitcnt vmcnt(4) lgkmcnt(0)\n\ts_barrier" ::: "memory");
        else ATT_WAIT_BAR();
        if (it > 0) { volatile LAS3 unsigned* f = flg + ((it - 1) & 1) * 8; unsigned all = f[0] & f[1] & f[2] & f[3] & f[4] & f[5] & f[6] & f[7]; if (__builtin_amdgcn_readfirstlane(all)) break; }
        if (it + 2 < ND) MB_DMA2(ksrc, vsrc, asc ? dt + 2 : dt - 2, (s3 == 0 ? 2 : s3 - 1));
        s3 = (s3 == 2) ? 0 : s3 + 1;
        const int pb = dt >> 1, jb = dt - 2 * own;
        const bool selme = (jb >= 0) || ((sel >> pb) & 1u);
        const bool active = !wdone && ((jb >= 0) ? (128 * jb <= 32 * wid + 31) : (__builtin_amdgcn_ballot_w64(selme) != 0ull));
        if (active && false) {
            const int istar = (jb >= 0) ? wid - 4 * jb : 4;
            const float basev = slope2 * (float)(128 * dt + 4 * hi - (q0 + qrel)) - Bq;
            const int kb = (int)(lds0 + L_K3) + slot * 2 * SLOTB + r32 * 128; const int ksw = (r32 >> 1) & 7;
            const int kbd[4] = {kb + (((0 + hi) ^ ksw) << 4), kb + (((2 + hi) ^ ksw) << 4), kb + (((4 + hi) ^ ksw) << 4), kb + (((6 + hi) ^ ksw) << 4)};
#define MB_KREAD(F, D0, OFF) asm volatile("ds_read_b128 %0,%1 offset:%c2" : "=&v"(F) : "v"(kbd[D0]), "i"(OFF) : "memory")
            bf16x8 fa[8], fb[8];
#pragma unroll
            for (int d0 = 0; d0 < 4; ++d0) { MB_KREAD(fa[2 * d0], d0, 0); MB_KREAD(fa[2 * d0 + 1], d0, 4096); }
            f32x16 p0, p1, p2, p3;
#define MB_CIN(P, I) do { const float bi_ = (selme && (I) <= istar) ? basev + (float)(I) * d32 : -INFINITY; \
                _Pragma("unroll") for (int r = 0; r < 16; ++r) P[r] = __builtin_fmaf(slope2, (float)((r & 3) + 8 * (r >> 2)), bi_); \
                if ((I) == istar) { _Pragma("unroll") for (int r = 0; r < 16; ++r) if (crow(r, hi) > r32) P[r] = -INFINITY; } } while (0)
            MB_CIN(p0, 0); MB_CIN(p1, 1); MB_CIN(p2, 2); MB_CIN(p3, 3);
#undef MB_CIN
            asm volatile("s_waitcnt lgkmcnt(0)" ::: "memory"); __builtin_amdgcn_sched_barrier(0);
#pragma unroll
            for (int d0 = 0; d0 < 4; ++d0) { MB_KREAD(fb[2 * d0], d0, SLOTB); MB_KREAD(fb[2 * d0 + 1], d0, SLOTB + 4096); }
            __builtin_amdgcn_sched_barrier(0);
#pragma unroll
            for (int d0 = 0; d0 < 4; ++d0) { p0 = __builtin_amdgcn_mfma_f32_32x32x16_bf16(fa[2 * d0], qr[d0], p0, 0, 0, 0); p1 = __builtin_amdgcn_mfma_f32_32x32x16_bf16(fa[2 * d0 + 1], qr[d0], p1, 0, 0, 0); }
            const int vb = vb0 + slot * 2 * SLOTB;
            s16x4 vlo[4], vhi[4], wlo[4], whi[4];
#define MB_VREADS(LO, HI, VB, D0) do { _Pragma("unroll") for (int ks = 0; ks < 4; ++ks) { \
                asm volatile("ds_read_b64_tr_b16 %0,%1 offset:%c2" : "=&v"(LO[ks]) : "v"(VB), "i"((D0) * 4096 + ks * 1024) : "memory"); \
                asm volatile("ds_read_b64_tr_b16 %0,%1 offset:%c2" : "=&v"(HI[ks]) : "v"(VB), "i"((D0) * 4096 + ks * 1024 + 512) : "memory"); } } while (0)
#define MB_LSUM(PA0, PA1, PA2, PA3) do { lvec = __builtin_amdgcn_mfma_f32_32x32x16_bf16(ONESA, PA0, lvec, 0, 0, 0); lvec = __builtin_amdgcn_mfma_f32_32x32x16_bf16(ONESA, PA1, lvec, 0, 0, 0); \
                lvec = __builtin_amdgcn_mfma_f32_32x32x16_bf16(ONESA, PA2, lvec, 0, 0, 0); lvec = __builtin_amdgcn_mfma_f32_32x32x16_bf16(ONESA, PA3, lvec, 0, 0, 0); } while (0)
#define MB_PK(LO, HI, k) (bf16x8){LO[k][0], LO[k][1], LO[k][2], LO[k][3], HI[k][0], HI[k][1], HI[k][2], HI[k][3]}
#define MB_PV(D0, LO, HI, PA0, PA1, PA2, PA3) do { \
                o[D0] = __builtin_amdgcn_mfma_f32_32x32x16_bf16(PA0, MB_PK(LO, HI, 0), o[D0], 0, 0, 0); o[D0] = __builtin_amdgcn_mfma_f32_32x32x16_bf16(PA1, MB_PK(LO, HI, 1), o[D0], 0, 0, 0); \
                o[D0] = __builtin_amdgcn_mfma_f32_32x32x16_bf16(PA2, MB_PK(LO, HI, 2), o[D0], 0, 0, 0); o[D0] = __builtin_amdgcn_mfma_f32_32x32x16_bf16(PA3, MB_PK(LO, HI, 3), o[D0], 0, 0, 0); } while (0)
            asm volatile("s_waitcnt lgkmcnt(0)" ::: "memory");
            MB_VREADS(vlo, vhi, vb, 0);
            __builtin_amdgcn_sched_barrier(0);
#pragma unroll
            for (int d0 = 0; d0 < 4; ++d0) { p2 = __builtin_amdgcn_mfma_f32_32x32x16_bf16(fb[2 * d0], qr[d0], p2, 0, 0, 0); p3 = __builtin_amdgcn_mfma_f32_32x32x16_bf16(fb[2 * d0 + 1], qr[d0], p3, 0, 0, 0); }
#pragma unroll
            for (int r = 0; r < 16; ++r) { p0[r] = ex2(p0[r]); p1[r] = ex2(p1[r]); }
            const bf16x8 a0 = pack8n(p0, 0), a1 = pack8n(p0, 8), a2 = pack8n(p1, 0), a3 = pack8n(p1, 8);
            __builtin_amdgcn_sched_barrier(0);
            asm volatile("s_waitcnt lgkmcnt(0)" ::: "memory");
            MB_VREADS(wlo, whi, vb, 1);
            __builtin_amdgcn_sched_barrier(0);
            MB_PV(0, vlo, vhi, a0, a1, a2, a3);
#pragma unroll
            for (int r = 0; r < 16; ++r) p2[r] = ex2(p2[r]);
            __builtin_amdgcn_sched_barrier(0);
            asm volatile("s_waitcnt lgkmcnt(0)" ::: "memory");
            MB_VREADS(vlo, vhi, vb + SLOTB, 0);
            __builtin_amdgcn_sched_barrier(0);
            MB_PV(1, wlo, whi, a0, a1, a2, a3);
            MB_LSUM(a0, a1, a2, a3);
#pragma unroll
            for (int r = 0; r < 16; ++r) p3[r] = ex2(p3[r]);
            const bf16x8 b0 = pack8n(p2, 0), b1 = pack8n(p2, 8), b2 = pack8n(p3, 0), b3 = pack8n(p3, 8);
            __builtin_amdgcn_sched_barrier(0);
            asm volatile("s_waitcnt lgkmcnt(0)" ::: "memory");
            MB_VREADS(wlo, whi, vb + SLOTB, 1);
            __builtin_amdgcn_sched_barrier(0);
            MB_PV(0, vlo, vhi, b0, b1, b2, b3);
            __builtin_amdgcn_sched_barrier(0);
            asm volatile("s_waitcnt lgkmcnt(0)" ::: "memory");
            __builtin_amdgcn_sched_barrier(0);
            MB_PV(1, wlo, whi, b0, b1, b2, b3);
            MB_LSUM(b0, b1, b2, b3);
#undef MB_PV
#undef MB_LSUM
#undef MB_PK
#undef MB_VREADS
#undef MB_KREAD
            mrun = Bq + lg2(lvec[0]);
        } else if (active) {
            f32x16 p0, p1, p2, p3, cin;
            const float base = selme ? slope2 * (float)(128 * dt + 4 * hi - (q0 + qrel)) : -INFINITY;
#pragma unroll
            for (int r = 0; r < 16; ++r) cin[r] = __builtin_fmaf(slope2, (float)((r & 3) + 8 * (r >> 2)), base);
            qkt(p0, p1, shm + L_K3 + slot * 2 * SLOTB, qr, cin, r32, hi);
            qkt(p2, p3, shm + L_K3 + slot * 2 * SLOTB + SLOTB, qr, cin, r32, hi);
            if (jb >= 0) {
#pragma unroll
                for (int r = 0; r < 16; ++r) { const int kv = 128 * jb + crow(r, hi);
                    if (kv > qrel) p0[r] = -INFINITY; if (kv + 32 > qrel) p1[r] = -INFINITY; if (kv + 64 > qrel) p2[r] = -INFINITY; if (kv + 96 > qrel) p3[r] = -INFINITY; }
            }
            float rm0 = p0[0], rm1 = p1[0], rm2 = p2[0], rm3 = p3[0];
#pragma unroll
            for (int r = 1; r < 16; ++r) { rm0 = fmaxf(rm0, p0[r]); rm1 = fmaxf(rm1, p1[r]); rm2 = fmaxf(rm2, p2[r]); rm3 = fmaxf(rm3, p3[r]); }
            float rm = fmaxf(fmaxf(rm0, rm1 + d32), fmaxf(rm2 + d64, rm3 + d96));
            rm = fmaxf(rm, __shfl_xor(rm, 32));
            const float mn = fmaxf(mrun, rm);
            if (__builtin_amdgcn_ballot_w64(mn > mrun) != 0ull) {
                const float alpha = ex2(mrun - mn); lrun *= alpha;
                if (hi == 0) wsf[r32] = alpha;
                asm volatile("s_waitcnt lgkmcnt(0)" ::: "memory");
#pragma unroll
                for (int r = 0; r < 16; ++r) { const float a = wsf[crow(r, hi)]; o[0][r] *= a; o[1][r] *= a; }
            }
            mrun = mn;
            const float mn1 = mn - d32, mn2 = mn - d64, mn3 = mn - d96; float sum = 0.f;
#pragma unroll
            for (int r = 0; r < 16; ++r) { p0[r] = ex2(p0[r] - mn); p1[r] = ex2(p1[r] - mn1); p2[r] = ex2(p2[r] - mn2); p3[r] = ex2(p3[r] - mn3); sum += (p0[r] + p1[r]) + (p2[r] + p3[r]); }
            lrun += sum;
            pv(o, vb0 + slot * 2 * SLOTB, pack8(p0, 0), pack8(p0, 8), pack8(p1, 0), pack8(p1, 8));
            pv(o, vb0 + slot * 2 * SLOTB + SLOTB, pack8(p2, 0), pack8(p2, 8), pack8(p3, 0), pack8(p3, 8));
        }
        { const float ub = slope2 * (float)(128 * (dt - 1) + 127 - (q0 + qrel)) + qn * kmax;
          const bool done = !asc && (dt <= 2 * own) && (__builtin_amdgcn_ballot_w64(!(ub < mrun - MB_EXIT)) == 0ull); wdone = done; if (lane == 0) flg[(it & 1) * 8 + wid] = done ? 1u : 0u; }
    }
    }
    lrun += __shfl_xor(lrun, 32);
    if (fast) lrun = lvec[0];
    if (hi == 0) wsf[32 + r32] = lrun;
    asm volatile("s_waitcnt lgkmcnt(0)" ::: "memory");
    float rli[16];
#pragma unroll
    for (int r = 0; r < 16; ++r) rli[r] = __builtin_amdgcn_rcpf(wsf[32 + crow(r, hi)]);
    ATT_WAIT_BAR();
    if (h < 7) { const int own1 = MB_OWN(h + 1); MB_DMA2(ksrc + HD, vsrc + HD, MB_ASC(h + 1) ? 0 : 2 * own1 + 1, 0);
#pragma unroll
        for (int d0 = 0; d0 < 4; ++d0) qr[d0] = *(const bf16x8*)((const char*)(Q + (rowbase + own1 * 256 + wid * 32) * AW + (h + 1) * HD) + qoff + d0 * 32); }
    store_o(o, rli, O + (rowbase + q0 + wid * 32) * AW + h * HD, shm, L_OST, wid, lane, r32, hi);
    asm volatile("s_waitcnt lgkmcnt(0)\n\ts_barrier" ::: "memory");
  }
    __builtin_amdgcn_s_setprio(0);
    ATT_WAIT_BAR();
#undef MB_OWN
#undef MB_ASC
#undef ksrc
#undef vsrc
#undef MB_DMA2
}
__device__ __forceinline__ void moba_kmean(int b, int h, const bf16_t* __restrict__ K, float* kmg, float* kmx, LAS3 unsigned char* shm) {
    int tid_ = threadIdx.x; asm volatile("" : "+v"(tid_)); const int tid = tid_, blk = tid >> 6, g = (tid >> 3) & 7, c = tid & 7;
    const bf16_t* kp = K + ((size_t)b * S + blk * 256 + g) * AW + h * HD + c * 8;
    float s[8]; float nmax = 0.f;
#pragma unroll
    for (int j = 0; j < 8; ++j) s[j] = 0.f;
    for (int r0 = 0; r0 < 32; r0 += 8) {
        u32x4 wv[8];
#pragma unroll
        for (int i = 0; i < 8; ++i) wv[i] = *(const u32x4*)(kp + (size_t)(8 * (r0 + i)) * AW);
        asm volatile("" ::: "memory");
#pragma unroll
        for (int i = 0; i < 8; ++i) { const u32x4 w = wv[i];
            const float e0 = __uint_as_float(w.x << 16), e1 = __uint_as_float(w.x & 0xffff0000u), e2 = __uint_as_float(w.y << 16), e3 = __uint_as_float(w.y & 0xffff0000u);
            const float e4 = __uint_as_float(w.z << 16), e5 = __uint_as_float(w.z & 0xffff0000u), e6 = __uint_as_float(w.w << 16), e7 = __uint_as_float(w.w & 0xffff0000u);
            s[0] += e0; s[1] += e1; s[2] += e2; s[3] += e3; s[4] += e4; s[5] += e5; s[6] += e6; s[7] += e7;
            float n2 = (e0 * e0 + e1 * e1) + (e2 * e2 + e3 * e3) + (e4 * e4 + e5 * e5) + (e6 * e6 + e7 * e7);
            n2 += __shfl_xor(n2, 1); n2 += __shfl_xor(n2, 2); n2 += __shfl_xor(n2, 4);
            nmax = fmaxf(nmax, n2); }
    }
#pragma unroll
    for (int of = 8; of < 64; of <<= 1) nmax = fmaxf(nmax, __shfl_xor(nmax, of));
    LAS3 float* red = (LAS3 float*)(shm + L_RED);
#pragma unroll
    for (int j = 0; j < 8; ++j) red[(blk * 8 + g) * 64 + c * 8 + j] = s[j];
    LAS3 float* nred = (LAS3 float*)(shm + L_WS);
    if ((tid & 63) == 0) nred[blk] = nmax;
    ATT_WAIT_BAR();
    { const int d = tid & 63; float a = 0.f;
#pragma unroll
      for (int gg = 0; gg < 8; ++gg) a += red[(blk * 8 + gg) * 64 + d];
      kmg[blk * 64 + d] = a * (1.f / 256.f);
      if (tid == 0) { float m = nred[0];
#pragma unroll
          for (int i = 1; i < 8; ++i) m = fmaxf(m, nred[i]);
          kmx[0] = __builtin_sqrtf(m) * 1.0001f; } }
    ATT_WAIT_BAR();
}
__device__ __forceinline__ void moba_stage_kmean(int b, const float* kmg_all, const float* kmx_all, LAS3 unsigned char* shm) {
    int tid_ = threadIdx.x; asm volatile("" : "+v"(tid_)); const int tid = tid_;
    LAS3 float* km = (LAS3 float*)(shm + L_KM);
    float kv[8];
#pragma unroll
    for (int i = 0; i < 8; ++i) kv[i] = kmg_all[(size_t)(b * 8 + i) * 512 + tid];
    asm volatile("" ::: "memory");
#pragma unroll
    for (int i = 0; i < 8; ++i) km[i * 512 + tid] = kv[i];
    if (tid < 8) ((LAS3 float*)(shm + L_KMX))[tid] = kmx_all[b * 8 + tid];
    ATT_WAIT_BAR();
}
__device__ __forceinline__ void conv_tile(int tile, const bf16_t* __restrict__ glu, const float* wdw, const float* bdw, const float* lng, const float* lnb, bf16_t* out, LAS3 unsigned char* shm) {
    int tid_ = threadIdx.x; asm volatile("" : "+v"(tid_)); const int tid = tid_, lane = tid & 63; const int wid = __builtin_amdgcn_readfirstlane(tid >> 6);
    const int m0 = tile * 256, t0 = m0 % S;
    typedef float f32x2 __attribute__((ext_vector_type(2)));
    f32x2 we[15], wo[15]; float w0, w30;
    { float w[CW];
#pragma unroll
      for (int j = 0; j < CW; ++j) w[j] = wdw[j * CC + tid];
#pragma unroll
      for (int k = 0; k < 15; ++k) { we[k] = f32x2{w[2 * k], w[2 * k + 1]}; wo[k] = f32x2{w[2 * k + 1], w[2 * k + 2]}; }
      w0 = w[0]; w30 = w[30]; }
    const float bias = bdw[tid];
    f32x4 g0 = *(const f32x4*)(lng + 8 * lane), g1 = *(const f32x4*)(lng + 8 * lane + 4), b0 = *(const f32x4*)(lnb + 8 * lane), b1 = *(const f32x4*)(lnb + 8 * lane + 4);
    f32x2 x2[31]; float xn[32];
    { float x[32 + CW - 1];
#pragma unroll
      for (int i = 0; i < 32 + CW - 1; ++i) { const int tt = i - (CW - 1); const int tc = (t0 + tt >= 0) ? tt : -t0;
          x[i] = __uint_as_float((unsigned)glu[(size_t)(m0 + tc) * CC + tid]); }
      asm volatile("" ::: "memory");
#pragma unroll
      for (int i = 0; i < 32 + CW - 1; ++i) { const int tt = i - (CW - 1); x[i] = (t0 + tt >= 0) ? __uint_as_float(__float_as_uint(x[i]) << 16) : 0.f; }
#pragma unroll
      for (int k = 0; k < 31; ++k) x2[k] = f32x2{x[2 * k], x[2 * k + 1]}; }
    for (int ch = 0; ch < 8; ++ch) {
        const int tb = 32 * ch;
        LAS3 float* tl = (LAS3 float*)(shm + L_CONV + (ch & 1) * 65536);
        if (ch < 7) {
#pragma unroll
            for (int i = 0; i < 32; ++i) xn[i] = __uint_as_float((unsigned)glu[(size_t)(m0 + tb + 32 + i) * CC + tid]);
            asm volatile("" ::: "memory");
        }
#pragma unroll
        for (int m = 0; m < 16; ++m) { f32x2 ae = f32x2{bias, 0.f}, ao = f32x2{bias, 0.f};
#pragma unroll
            for (int k = 0; k < 15; ++k) { ae = __builtin_elementwise_fma(we[k], x2[m + k], ae); ao = __builtin_elementwise_fma(wo[k], x2[m + k + 1], ao); }
            tl[(2 * m) * CC + tid] = (ae.x + ae.y) + w30 * x2[m + 15].x; tl[(2 * m + 1) * CC + tid] = (ao.x + ao.y) + w0 * x2[m].y; }
        ATT_WAIT_BAR();
#pragma unroll
        for (int k = 0; k < 4; ++k) { const int tok = 4 * wid + k;
            const f32x4 v0 = *(const LAS3 f32x4*)(tl + tok * CC + 8 * lane), v1 = *(const LAS3 f32x4*)(tl + tok * CC + 8 * lane + 4);
            float s = (v0[0] + v0[1]) + (v0[2] + v0[3]) + (v1[0] + v1[1]) + (v1[2] + v1[3]);
#pragma unroll
            for (int of = 1; of < 64; of <<= 1) s += __shfl_xor(s, of);
            const float mean = s * (1.f / CC); const f32x4 d0 = v0 - mean, d1 = v1 - mean;
            float q = (d0[0] * d0[0] + d0[1] * d0[1]) + (d0[2] * d0[2] + d0[3] * d0[3]) + (d1[0] * d1[0] + d1[1] * d1[1]) + (d1[2] * d1[2] + d1[3] * d1[3]);
#pragma unroll
            for (int of = 1; of < 64; of <<= 1) q += __shfl_xor(q, of);
            const float rstd = __builtin_amdgcn_rsqf(q * (1.f / CC) + EPS);
            f32x4 y0 = d0 * rstd * g0 + b0, y1 = d1 * rstd * g1 + b1;
#pragma unroll
            for (int e = 0; e < 4; ++e) { y0[e] = y0[e] * __builtin_amdgcn_rcpf(1.f + ex2(-LOG2E * y0[e])); y1[e] = y1[e] * __builtin_amdgcn_rcpf(1.f + ex2(-LOG2E * y1[e])); }
            u32x4 pk; pk.x = cvtpk(y0[0], y0[1]); pk.y = cvtpk(y0[2], y0[3]); pk.z = cvtpk(y1[0], y1[1]); pk.w = cvtpk(y1[2], y1[3]);
            *(u32x4*)(out + (size_t)(m0 + tb + tok) * CC + 8 * lane) = pk; }
#pragma unroll
        for (int k = 0; k < 15; ++k) x2[k] = x2[k + 16];
#pragma unroll
        for (int q = 0; q < 16; ++q) x2[15 + q] = f32x2{__uint_as_float(__float_as_uint(xn[2 * q]) << 16), __uint_as_float(__float_as_uint(xn[2 * q + 1]) << 16)};
    }
    ATT_WAIT_BAR();
}
#undef LAS3
}

#define GAS __attribute__((address_space(1)))
#define LAS __attribute__((address_space(3)))
typedef unsigned short bf16;
typedef unsigned v4u __attribute__((ext_vector_type(4)));
typedef float f32x4 __attribute__((ext_vector_type(4)));
typedef unsigned u32x2 __attribute__((ext_vector_type(2)));
typedef GAS unsigned gu32;
#define LDS_WAIT() asm volatile("s_waitcnt lgkmcnt(0)" ::: "memory")

#define XB_TMO      128
#define XB_XCNT(j)  (256  + 64 * (j))
#define XB_XSUB(j)  (1280 + 64 * (j))
#define XB_XGEN(j)  (2304 + 64 * (j))
#define XB_TOP      3328
#define XB_TOPGEN   3392
#define XCD_BAR_WORDS 3456
#define XB_SPIN_CAP (1u << 18)

__device__ __forceinline__ unsigned xb_ld(unsigned* p)              { return __hip_atomic_load(p, __ATOMIC_RELAXED, __HIP_MEMORY_SCOPE_AGENT); }
__device__ __forceinline__ unsigned xb_add(unsigned* p, unsigned v) { return __hip_atomic_fetch_add(p, v, __ATOMIC_RELAXED, __HIP_MEMORY_SCOPE_AGENT); }
__device__ __forceinline__ unsigned xb_xcc_id() { return (unsigned)__builtin_amdgcn_s_getreg((3 << 11) | 20) & 0xFu; }
#define XB_SPIN(cond, bar) do { unsigned _sp = 0; while (cond) { __builtin_amdgcn_s_sleep(1); \
    if ((++_sp & 255u) == 0u) { if (xb_ld(&(bar)[XB_TMO])) break; if (_sp > XB_SPIN_CAP) { atomicAdd(&(bar)[XB_TMO], 1u); break; } } } } while (0)

struct XcdBarrier {
    unsigned* bar; unsigned x;
    volatile LAS unsigned* st;
};

__device__ __forceinline__ XcdBarrier xcd_barrier_post(unsigned* bar, volatile LAS unsigned* st) {
    XcdBarrier b; b.bar = bar; b.x = xb_xcc_id(); b.st = st;
    if (threadIdx.x == 0) (void)xb_add(&bar[XB_XCNT(b.x)], 1u);
    return b;
}
__device__ __forceinline__ void xcd_barrier_complete(unsigned* bar, unsigned x, unsigned& nloc, unsigned& nx) {
    const unsigned G = gridDim.x * gridDim.y * gridDim.z;
    unsigned sum, cnt, mine, sp = 0u;
    for (;;) {
        sum = 0u; cnt = 0u; mine = 0u;
#pragma unroll
        for (unsigned j = 0; j < 16; ++j) { const unsigned c = xb_ld(&bar[XB_XCNT(j)]); sum += c; cnt += (c > 0u) ? 1u : 0u; mine = (j == x) ? c : mine; }
        if (sum == G) break;
        __builtin_amdgcn_s_sleep(1);
        if ((++sp & 255u) == 0u) { if (xb_ld(&bar[XB_TMO])) break; if (sp > XB_SPIN_CAP) { atomicAdd(&bar[XB_TMO], 1u); break; } }
    }
    nloc = mine > 0u ? mine : 1u; nx = cnt > 0u ? cnt : 1u;
}

__device__ __forceinline__ void xcd_barrier(const XcdBarrier& b) {
    asm volatile("s_waitcnt vmcnt(0)" ::: "memory");
    __syncthreads();
    if (threadIdx.x == 0) {
        unsigned* bar = b.bar;
        __builtin_amdgcn_s_waitcnt(0);
        unsigned nloc = b.st[0], nx = b.st[1];
        if (nloc == 0u) { xcd_barrier_complete(bar, b.x, nloc, nx); b.st[0] = nloc; b.st[1] = nx; }
        const unsigned old = xb_add(&bar[XB_XSUB(b.x)], 1u);
        const unsigned gen = old / nloc;
        if (old + 1u == (gen + 1u) * nloc) {
            __builtin_amdgcn_fence(__ATOMIC_RELEASE, "agent");
            asm volatile("s_waitcnt vmcnt(0)" ::: "memory");
            const unsigned og = xb_add(&bar[XB_TOP], 1u);
            const unsigned tg = og / nx;
            if (og + 1u == (tg + 1u) * nx) xb_add(&bar[XB_TOPGEN], 1u);
            else XB_SPIN(xb_ld(&bar[XB_TOPGEN]) == tg, bar);
            __builtin_amdgcn_fence(__ATOMIC_ACQUIRE, "agent");
            xb_add(&bar[XB_XGEN(b.x)], 1u);
            asm volatile("s_waitcnt vmcnt(0)" ::: "memory");
        } else {
            XB_SPIN(xb_ld(&bar[XB_XGEN(b.x)]) == gen, bar);
            __builtin_amdgcn_fence(__ATOMIC_ACQUIRE, "agent");
            asm volatile("s_waitcnt vmcnt(0)" ::: "memory");
        }
    }
    __syncthreads();
}

constexpr int NWAVES = 8;
constexpr int RING_OFF = 0, RING_BYTES = 131072;
constexpr int LDSCTL_OFF = RING_BYTES, MISC_OFF = LDSCTL_OFF + 320;
constexpr int LDS_BYTES = 147456;
constexpr int CW_BAR = 4096;
constexpr int MAX_LAUNCHES = 24;
static_assert((CW_BAR + MAX_LAUNCHES * XCD_BAR_WORDS) * 4 <= (int)WS_SSQ, "barrier words below the row statistics");
constexpr int N_PHASES = 18;

struct Args { const float* in[19]; float* out; unsigned char* ws; int ph_lo, ph_hi, li, pad; };

struct WDesc { const float* src; const float* gain; bf16* dst; int K, N, Nsrc, map; };
__device__ __forceinline__ int map_col(int map, int n) {
    if (map == 1) { const int pn = n >> 8, j = n & 255; return j < 128 ? 128 * pn + j : DFF + 128 * pn + (j - 128); }
    if (map == 2) { if (n < 3072 || n >= 4096) return n; const int pn = (n - 3072) >> 8, j = n & 255; return j < 128 ? 3072 + 128 * pn + j : 3072 + 512 + 128 * pn + (j - 128); }
    return n;
}
__device__ __forceinline__ WDesc get_wdesc(const Args& a, int wi) {
    const int l = wi / 9, k = wi % 9; unsigned char* wl = a.ws + WS_W + (size_t)l * W_LAYER; WDesc w;
    switch (k) {
    case 0: w = WDesc{a.in[2] + (size_t)l * D * NFF, a.in[1] + (size_t)l * D, (bf16*)(wl + W_F1I), D, NFF, NFF, 1}; break;
    case 1: w = WDesc{a.in[3] + (size_t)l * DFF * D, nullptr, (bf16*)(wl + W_F1O), DFF, D, D, 0}; break;
    case 2: w = WDesc{a.in[5] + (size_t)l * D * NIN, a.in[4] + (size_t)l * D, (bf16*)(wl + W_IN), D, NIN, NIN, 2}; break;
    case 3: w = WDesc{a.in[7] + (size_t)l * AW * D, nullptr, (bf16*)(wl + W_OUT3), AW, D, D, 0}; break;
    case 4: w = WDesc{a.in[8] + (size_t)l * AW * D, nullptr, (bf16*)(wl + W_OUT3 + 1 * MiB), AW, D, D, 0}; break;
    case 5: w = WDesc{a.in[13] + (size_t)l * CC * D, nullptr, (bf16*)(wl + W_OUT3 + 2 * MiB), CC, D, D, 0}; break;
    case 6: w = WDesc{a.in[14] + (size_t)l * D * D, nullptr, (bf16*)(wl + W_O), D, D, D, 0}; break;
    case 7: w = WDesc{a.in[16] + (size_t)l * D * NFF, a.in[15] + (size_t)l * D, (bf16*)(wl + W_F2I), D, NFF, NFF, 1}; break;
    default: w = WDesc{a.in[17] + (size_t)l * DFF * D, nullptr, (bf16*)(wl + W_F2O), DFF, D, D, 0}; break;
    }
    return w;
}
__device__ __forceinline__ void transpose_item(const WDesc& w, LAS float* scr, int item, int lane) {
    const int nblk = w.N / 32, kb = item / nblk, nb = item % nblk, k0 = 64 * kb, n0 = 32 * nb;
    const int s0 = map_col(w.map, n0);
    float tv[32];
#pragma unroll
    for (int i = 0; i < 32; ++i) tv[i] = w.src[(size_t)(k0 + 2 * i + (lane >> 5)) * w.Nsrc + s0 + (lane & 31)];
    if (w.gain) {
#pragma unroll
        for (int i = 0; i < 32; ++i) tv[i] *= w.gain[k0 + 2 * i + (lane >> 5)]; }
#pragma unroll
    for (int i = 0; i < 32; ++i) scr[(2 * i + (lane >> 5)) * 33 + (lane & 31)] = tv[i];
    LDS_WAIT(); asm volatile("" ::: "memory");
    const int c = lane & 7;
#pragma unroll
    for (int j = 0; j < 4; ++j) { const int n = (lane >> 3) + 8 * j; const LAS float* s = scr + (8 * c) * 33 + n;
        v4u o; o.x = pg8::cvt_pk_bf16(s[0 * 33], s[1 * 33]); o.y = pg8::cvt_pk_bf16(s[2 * 33], s[3 * 33]); o.z = pg8::cvt_pk_bf16(s[4 * 33], s[5 * 33]); o.w = pg8::cvt_pk_bf16(s[6 * 33], s[7 * 33]);
        *(GAS v4u*)(w.dst + (size_t)(n0 + n) * w.K + k0 + 8 * c) = o; }
    LDS_WAIT(); asm volatile("" ::: "memory");
}
__device__ __forceinline__ float wave_sum(float v) {
#pragma unroll
    for (int o = 1; o < 64; o <<= 1) v += __shfl_xor(v, o);
    return v;
}

__global__ void __launch_bounds__(NWAVES * 64, 2) mk_fwd(Args args) {
    extern __shared__ __attribute__((aligned(16))) unsigned char lds[];
    LAS unsigned char* const L = (LAS unsigned char*)lds;
    volatile LAS unsigned* const MISC = (volatile LAS unsigned*)(L + MISC_OFF);
    const int tid = threadIdx.x;
    const int G = gridDim.x; const int vcu = (G % 8 == 0) ? ((int)blockIdx.x % 8) * (G / 8) + (int)blockIdx.x / 8 : (int)blockIdx.x;
    unsigned char* const ws = args.ws;
    gu32* const ctl = (gu32*)(ws + WS_CTL);
    for (int u = tid; u < (LDS_BYTES - LDSCTL_OFF) / 4; u += NWAVES * 64) ((LAS unsigned*)(L + LDSCTL_OFF))[u] = 0u;
    __syncthreads();
    XcdBarrier bar = xcd_barrier_post((unsigned*)(ctl + CW_BAR) + args.li * XCD_BAR_WORDS, MISC + 8);
    const int lo = args.ph_lo, hi = args.ph_hi;
#define IN(k) (lo <= (k) && (k) < hi)
#define SEAM(k) do { if (IN(k) && IN((k) + 1)) xcd_barrier(bar); } while (0)
    bf16* const Hh = (bf16*)(ws + WS_H); bf16* const ACT = (bf16*)(ws + WS_ACT);
    bf16* const QA = (bf16*)(ws + WS_QA); bf16* const KA = (bf16*)(ws + WS_KA); bf16* const VA = (bf16*)(ws + WS_VA);
    bf16* const QB = (bf16*)(ws + WS_QB); bf16* const KB = (bf16*)(ws + WS_KB); bf16* const VB = (bf16*)(ws + WS_VB);
    bf16* const GLU = (bf16*)(ws + WS_GLU); bf16* const CONVO = (bf16*)(ws + WS_CONVO); bf16* const GC = (bf16*)(ws + WS_GC); bf16* const MIXED = (bf16*)(ws + WS_MIXED);
    bf16* const GA = (bf16*)args.out; bf16* const GB = (bf16*)args.out + (size_t)M * D;
    unsigned* const ssq = (unsigned*)(ws + WS_SSQ);

    if (IN(0)) {
        int tl_ = threadIdx.x; asm volatile("" : "+v"(tl_)); const int lane = tl_ & 63, wave = __builtin_amdgcn_readfirstlane(tl_ >> 6);
        LAS float* scr = (LAS float*)(L + RING_OFF + wave * 16384);
        const int gw = vcu * NWAVES + wave, NGW = G * NWAVES;
        {
        for (int wi = 0; wi < 18; ++wi) {
            const WDesc w = get_wdesc(args, wi);
            const int nitems = (w.K / 64) * (w.N / 32);
            for (int it = gw; it < nitems; it += NGW) transpose_item(w, scr, it, lane);
        }
        const float* x = args.in[0];
        for (int m4 = gw * 4; m4 < M; m4 += NGW * 4) {
            f32x4 v[4][4];
#pragma unroll
            for (int rr4 = 0; rr4 < 4; ++rr4)
#pragma unroll
                for (int j = 0; j < 4; ++j) v[rr4][j] = *((const GAS f32x4*)(x + (size_t)(m4 + rr4) * D) + lane + 64 * j);
#pragma unroll
            for (int rr4 = 0; rr4 < 4; ++rr4) { float s = 0.f;
#pragma unroll
                for (int j = 0; j < 4; ++j) { const f32x4 t = v[rr4][j]; s += (t.x * t.x + t.y * t.y) + (t.z * t.z + t.w * t.w);
                    u32x2 o; o.x = pg8::cvt_pk_bf16(t.x, t.y); o.y = pg8::cvt_pk_bf16(t.z, t.w); *((GAS u32x2*)(Hh + (size_t)(m4 + rr4) * D) + lane + 64 * j) = o; }
                s = wave_sum(s);
                if (lane == 0) ssq[m4 + rr4] = (unsigned)(s * SSQ_FIX + 0.5f); }
        }
        }
    }
    SEAM(0);

    for (int l = 0; l < DEPTH; ++l) {
        const int pb = 1 + 8 * l;
        unsigned char* const wl = ws + WS_W + (size_t)l * W_LAYER;
        for (int half = 0; half < 2; ++half) {
            if (IN(pb + 6 * half)) {
                pg8::Gemm g{Hh, (const bf16*)(wl + (half ? W_F2I : W_F1I)), M, NFF, D}; pg8::StaticOrder So; So.init(M, NFF, G, (int)blockIdx.x);
                pg8::EpiSwiglu E{ACT, pg8::RowScale{ssq + (size_t)(3 * l + 2 * half) * M, 0u, 0u}, L};
                pg8::gemm_phase<pg8::EpiSwiglu, pg8::StaticOrder, true, true>(L + RING_OFF, g, So, E);
            }
            SEAM(pb + 6 * half);
            if (IN(pb + 1 + 6 * half)) {
                pg8::Gemm g{ACT, (const bf16*)(wl + (half ? W_F2O : W_F1O)), M, D, DFF}; pg8::StaticOrder So; So.init(M, D, G, (int)blockIdx.x);
                { pg8::EpiRes E{Hh, ssq + (size_t)(3 * l + 1 + 2 * half) * M, 0.5f};
                pg8::gemm_phase<pg8::EpiRes, pg8::StaticOrder, true, true>(L + RING_OFF, g, So, E); }
            }
            SEAM(pb + 1 + 6 * half);
            if (half == 0) {
                if (IN(pb + 2)) {
                    pg8::Gemm g{Hh, (const bf16*)(wl + W_IN), M, NIN, D}; pg8::StaticOrder So; So.init(M, NIN, G, (int)blockIdx.x);
                    pg8::EpiWin E{QA, GLU, GA, GB, GC, args.in[6] + (size_t)l * 3 * D, pg8::RowScale{ssq + (size_t)(3 * l + 1) * M, 0u, 0u}, L};
                    pg8::gemm_phase<pg8::EpiWin, pg8::StaticOrder, true, true>(L + RING_OFF, g, So, E);
                }
                SEAM(pb + 2);
                if (IN(pb + 3)) {
                    float* const KMG = (float*)(ws + WS_KMEAN); float* const KMX = KMG + 256 * 512;
                    for (int bh = vcu; bh < NB * NH; bh += G) att::moba_kmean(bh >> 3, bh & 7, KB, KMG + (size_t)bh * 512, KMX + bh, L + RING_OFF);
                    xcd_barrier(bar);
                    for (int bh = vcu; bh < NB * NH; bh += G) { const int b = bh >> 3, h = bh & 7;
                        att::sb_units(b, h, QA, KA, VA, QA, L + RING_OFF); }
                    for (int tile = vcu; tile < M / 256; tile += G)
                        att::conv_tile(tile, GLU, args.in[9] + (size_t)l * CW * CC, args.in[10] + (size_t)l * CC, args.in[11] + (size_t)l * CC, args.in[12] + (size_t)l * CC, CONVO, L + RING_OFF);
                    {
                        for (int bj = vcu; bj < NB * 8; bj += G) { const int b = bj >> 3, j = bj & 7;
                            att::moba_stage_kmean(b, KMG, KMX, L + RING_OFF);
                            att::moba_units(b, j, QB, KB, VB, QB, L + RING_OFF); }
                    }
                }
                SEAM(pb + 3);
                if (IN(pb + 4)) {
                    pg8::Gemm g{QA, (const bf16*)(wl + W_OUT3), 3 * M, 3 * D, AW}; pg8::MixOrder So; So.base.init(M, D, G, (int)blockIdx.x);
                    pg8::EpiMix E{GA, GB, GC, MIXED};
                    pg8::gemm_phase<pg8::EpiMix, pg8::MixOrder, true, true>(L + RING_OFF, g, So, E);
                }
                SEAM(pb + 4);
                if (IN(pb + 5)) {
                    pg8::Gemm g{MIXED, (const bf16*)(wl + W_O), M, D, D}; pg8::StaticOrder So; So.init(M, D, G, (int)blockIdx.x);
                    { pg8::EpiRes E{Hh, ssq + (size_t)(3 * l + 2) * M, 1.0f};
                    pg8::gemm_phase<pg8::EpiRes, pg8::StaticOrder, true, true>(L + RING_OFF, g, So, E); }
                }
                SEAM(pb + 5);
            }
        }
    }
    if (IN(17)) {
        int tl_ = threadIdx.x; asm volatile("" : "+v"(tl_)); const int lane = tl_ & 63, wave = __builtin_amdgcn_readfirstlane(tl_ >> 6);
        const int gw = vcu * NWAVES + wave, NGW = G * NWAVES; const float* gn = args.in[18];
        f32x4 gv[4];
#pragma unroll
        for (int j = 0; j < 4; ++j) gv[j] = *((const GAS f32x4*)gn + lane + 64 * j);
        for (int m4 = gw * 4; m4 < M; m4 += NGW * 4) {
            u32x2 raw[4][4];
#pragma unroll
            for (int rr4 = 0; rr4 < 4; ++rr4)
#pragma unroll
                for (int j = 0; j < 4; ++j) raw[rr4][j] = *((const GAS u32x2*)(Hh + (size_t)(m4 + rr4) * D) + lane + 64 * j);
            asm volatile("" ::: "memory");
#pragma unroll
            for (int rr4 = 0; rr4 < 4; ++rr4) { float v[16]; float s = 0.f;
#pragma unroll
                for (int j = 0; j < 4; ++j) { const u32x2 w = raw[rr4][j];
                    v[4 * j + 0] = __uint_as_float(w.x << 16); v[4 * j + 1] = __uint_as_float(w.x & 0xffff0000u); v[4 * j + 2] = __uint_as_float(w.y << 16); v[4 * j + 3] = __uint_as_float(w.y & 0xffff0000u);
                    s += (v[4 * j] * v[4 * j] + v[4 * j + 1] * v[4 * j + 1]) + (v[4 * j + 2] * v[4 * j + 2] + v[4 * j + 3] * v[4 * j + 3]); }
                s = wave_sum(s);
                const float rs = __builtin_amdgcn_rsqf(s * (1.f / D) + EPS);
#pragma unroll
                for (int j = 0; j < 4; ++j) { f32x4 o; o.x = v[4 * j] * rs * gv[j].x; o.y = v[4 * j + 1] * rs * gv[j].y; o.z = v[4 * j + 2] * rs * gv[j].z; o.w = v[4 * j + 3] * rs * gv[j].w;
                    *((GAS f32x4*)(args.out + (size_t)(m4 + rr4) * D) + lane + 64 * j) = o; } }
        }
    }
#undef IN
#undef SEAM
}

static void launch_range(const Args& base, int lo, int hi, int& li, int grid, hipStream_t stream) {
    Args a = base; a.ph_lo = lo; a.ph_hi = hi; a.li = li++;
    hipLaunchKernelGGL(mk_fwd, dim3(grid), dim3(NWAVES * 64), LDS_BYTES, stream, a);
    const hipError_t le = hipPeekAtLastError();
    if (le != hipSuccess) fprintf(stderr, "kernel_launch: launch [%d,%d) failed: %s\n", lo, hi, hipGetErrorName(le));
}
extern "C" void kernel_launch(void* const* d_in, const int* in_sizes, int n_in, void* d_out, int out_size, void* d_ws, size_t ws_size, hipStream_t stream) {
    static int grid = 0;
    if (grid == 0) {
        if (n_in != 19 || in_sizes[0] != M * D || out_size != M * D || ws_size < WS_END) { fprintf(stderr, "kernel_launch: unexpected shapes (n_in %d out %d ws %zu); nothing launched\n", n_in, out_size, ws_size); grid = -1; return; }
        int dev = 0, cus = 0, per_cu = 0;
        if (hipGetDevice(&dev) != hipSuccess || hipDeviceGetAttribute(&cus, hipDeviceAttributeMultiprocessorCount, dev) != hipSuccess) { grid = -1; return; }
        if (hipFuncSetAttribute((const void*)mk_fwd, hipFuncAttributeMaxDynamicSharedMemorySize, LDS_BYTES) != hipSuccess) { fprintf(stderr, "kernel_launch: hipFuncSetAttribute failed\n"); grid = -1; return; }
        if (hipOccupancyMaxActiveBlocksPerMultiprocessor(&per_cu, (const void*)mk_fwd, NWAVES * 64, LDS_BYTES) != hipSuccess || per_cu < 1) { fprintf(stderr, "kernel_launch: occupancy query reports %d workgroups per CU\n", per_cu); }
        (void)hipGetLastError();
        grid = cus;
    }
    if (grid < 0) return;
    if (hipMemsetAsync((char*)d_ws + WS_CTL, 0, CTL_BYTES, stream) != hipSuccess) return;
    Args a{};
    for (int i = 0; i < 19; ++i) a.in[i] = (const float*)d_in[i];
    a.out = (float*)d_out; a.ws = (unsigned char*)d_ws;
    int li = 0;
    launch_range(a, 0, N_PHASES, li, grid, stream);
}
```

```cpp
#include <hip/hip_runtime.h>
#include <cstdint>
#include <cstdio>

typedef unsigned long long u64;
constexpr int NB = 32, S = 2048, D = 1024, M = NB * S, DEPTH = 2;
constexpr int HD = 64, NH = 8, AW = 512, CC = 512, CW = 31;
constexpr int DFF = 2816, NFF = 2 * DFF, NIN = 7168;
constexpr float EPS = 1e-6f;
constexpr float LOG2E = 1.4426950408889634f, LN2 = 0.6931471805599453f;
constexpr float QSCALE = 0.125f * LOG2E;
constexpr float SSQ_FIX = 16384.f, SSQ_INV = 1.f / 16384.f;

constexpr size_t MiB = 1u << 20;
constexpr size_t WS_CTL = 0, CTL_BYTES = 4 * MiB;
constexpr size_t WS_SSQ = 512 * 1024;
constexpr size_t WS_W = 4 * MiB, W_LAYER = 52 * MiB;
constexpr size_t W_F1I = 0, W_F1O = 11534336, W_IN = 17301504, W_OUT3 = 31981568, W_O = 35127296, W_F2I = 37224448, W_F2O = 48758784;
static_assert(W_F2O + 5767168 == W_LAYER, "weights");
constexpr size_t WS_H = 108 * MiB;
constexpr size_t WS_ACT = 236 * MiB;
constexpr size_t WS_QA = 236 * MiB, WS_KA = 300 * MiB, WS_VA = 364 * MiB, WS_QB = 428 * MiB, WS_KB = 492 * MiB, WS_VB = 556 * MiB;
constexpr size_t WS_CONVO = 620 * MiB, WS_GLU = 684 * MiB, WS_GC = 748 * MiB, WS_KMEAN = 876 * MiB, WS_END = 877 * MiB;
constexpr size_t WS_MIXED = WS_KA;
static_assert(WS_QB - WS_QA == 192 * MiB && WS_CONVO - WS_QB == 192 * MiB, "the three out-projection A operands sit 192 MiB apart (MixOrder)");

namespace pg8 {
#define PG8_LAS __attribute__((address_space(3)))
typedef unsigned short bf16_t;
typedef short bf16x8 __attribute__((ext_vector_type(8)));
typedef float f32x4 __attribute__((ext_vector_type(4)));
typedef unsigned u32x4 __attribute__((ext_vector_type(4)));
constexpr int BM = 256, BK = 64, HALF = 128, HTB = HALF * BK * 2  , STAGE_BYTES = 8 * HTB, NXCD = 8, WGM = 8;

__host__ __device__ __forceinline__ int lds_byte(int r, int c) { const int st = (r >> 4) * 2 + (c >> 5), rr = r & 15, cc = c & 31, ob = rr * 64 + cc * 2; return st * 1024 + (ob ^ (((ob >> 9) & 1) << 5)); }
__host__ __device__ __forceinline__ void stage_rc(int b, int& R, int& C) { const int st = b / 1024, sb = b % 1024, swz = sb ^ (((sb >> 9) & 1) << 5); R = (st >> 1) * 16 + swz / 64; C = (st & 1) * 32 + (swz % 64) / 2; }
__host__ __device__ __forceinline__ int perm32(int rho) { const int n = rho >> 4, i = rho & 15; return 8 * (i >> 2) + 4 * n + (i & 3); }

struct Unit { int pm, pn; };
struct Gemm { const bf16_t* A; const bf16_t* Bt; int M, N, K; };

struct StaticOrder {
    int nM, nN, nwg, G, c;
    __host__ __device__ void init(int M, int N, int G_, int c_) { nM = M / BM; nN = N / BM; nwg = nM * nN; G = G_; c = c_; }
    __host__ __device__ bool next(int i, Unit& u) const {
        const long L = (long)i * G + c; if (L >= nwg) return false;
        int wgid = (int)L; { const int q = nwg / NXCD, r = nwg % NXCD, xcd = wgid % NXCD, off = wgid / NXCD; wgid = (xcd < r ? xcd * (q + 1) : r * (q + 1) + (xcd - r) * q) + off; }
        const int nig = WGM * nN, gid = wgid / nig, fm = gid * WGM, gsz = (nM - fm) < WGM ? (nM - fm) : WGM;
        u.pm = fm + ((wgid % nig) % gsz); u.pn = (wgid % nig) / gsz; return true;
    }
    __device__ __forceinline__ void a_ready(const Unit&) const {}
    __device__ __forceinline__ void done(const Unit&) const {}
};

__device__ __forceinline__ unsigned cvt_pk_bf16(float lo, float hi) { unsigned r; asm volatile("v_cvt_pk_bf16_f32 %0, %1, %2" : "=v"(r) : "v"(lo), "v"(hi)); return r; }
__device__ __forceinline__ float ex2(float x) { return __builtin_amdgcn_exp2f(x); }
__device__ __forceinline__ float rcpf_(float x) { return __builtin_amdgcn_rcpf(x); }
__device__ __forceinline__ float sigm(float x) { return rcpf_(1.f + ex2(-LOG2E * x)); }
__device__ __forceinline__ float bflo(unsigned w) { return __uint_as_float(w << 16); }
__device__ __forceinline__ float bfhi(unsigned w) { return __uint_as_float(w & 0xffff0000u); }
__device__ __forceinline__ u32x4 pack8(const f32x4 a, const f32x4 b) { u32x4 w; w.x = cvt_pk_bf16(a[0], a[1]); w.y = cvt_pk_bf16(a[2], a[3]); w.z = cvt_pk_bf16(b[0], b[1]); w.w = cvt_pk_bf16(b[2], b[3]); return w; }
__device__ __forceinline__ void unpack8(const u32x4 w, f32x4& a, f32x4& b) { a = (f32x4){bflo(w.x), bfhi(w.x), bflo(w.y), bfhi(w.y)}; b = (f32x4){bflo(w.z), bfhi(w.z), bflo(w.w), bfhi(w.w)}; }
__device__ __forceinline__ void st_nt(bf16_t* p, const u32x4 v) { __builtin_nontemporal_store(v, (u32x4*)p); }
typedef unsigned ssq_t;
constexpr int RS_LDS = 131072 + 2048;
struct RowScale {
    const ssq_t* ssq; unsigned p0, p1;
    __device__ __forceinline__ void prefetch(const Unit& u, int wr, int lane) { const ssq_t* s = ssq + u.pm * BM + wr * 64 + lane; p0 = s[0]; p1 = s[HALF]; }
    __device__ __forceinline__ void stash(PG8_LAS unsigned char* lds, int wid, int lane) const { PG8_LAS float* t = (PG8_LAS float*)(lds + RS_LDS) + wid * 128;
        t[lane] = __builtin_amdgcn_rsqf((float)p0 * (SSQ_INV / D) + EPS); t[64 + lane] = __builtin_amdgcn_rsqf((float)p1 * (SSQ_INV / D) + EPS); }
    __device__ __forceinline__ void get(PG8_LAS unsigned char* lds, int wid, int fr, float (&rs)[2][4]) const { const PG8_LAS float* t = (const PG8_LAS float*)(lds + RS_LDS) + wid * 128;
#pragma unroll
        for (int ai = 0; ai < 2; ++ai)
#pragma unroll
            for (int m = 0; m < 4; ++m) rs[ai][m] = t[ai * 64 + m * 16 + fr]; }
};

struct EpiSwiglu {
    static constexpr bool PERM = true, AFTER_DRAIN = false;
    bf16_t* O; RowScale R; PG8_LAS unsigned char* lds;
    __device__ __forceinline__ void prefetch(const Unit& u, int wr, int lane) { R.prefetch(u, wr, lane); }
    __device__ __forceinline__ void stash(int wid, int lane) const { R.stash(lds, wid, lane); }
    __device__ __forceinline__ bool operator()(f32x4 (&acc)[2][2][4][2], const Unit& u, int wr, int wc, int fr, int fq) const {
        const int row0 = u.pm * BM + wr * 64 + fr, col0 = u.pn * HALF + wc * 32 + 8 * fq;
        float rs[2][4]; R.get(lds, wr * 4 + wc, fr, rs);
#pragma unroll
        for (int ai = 0; ai < 2; ++ai)
#pragma unroll
            for (int m = 0; m < 4; ++m) { const float r = rs[ai][m], c1 = -LOG2E * r, ir2 = rcpf_(r * r); f32x4 o[2];
#pragma unroll
                for (int n = 0; n < 2; ++n) { const f32x4 a = acc[ai][0][m][n], t = a * c1; f32x4 d;
#pragma unroll
                    for (int k = 0; k < 4; ++k) d[k] = ex2(t[k]);
#pragma unroll
                    for (int k = 0; k < 4; ++k) d[k] = rcpf_(__builtin_fmaf(d[k], ir2, ir2));
                    o[n] = (a * acc[ai][1][m][n]) * d; }
                st_nt(O + (size_t)(row0 + ai * HALF + m * 16) * DFF + col0, pack8(o[0], o[1])); }
        return false;
    }
};
struct EpiRes {
    static constexpr bool PERM = true, AFTER_DRAIN = false;
    bf16_t* Hh; ssq_t* ssq_out; float scale;
    __device__ __forceinline__ void prefetch(const Unit&, int, int) {}
    __device__ __forceinline__ void stash(int, int) const {}
    __device__ __forceinline__ bool operator()(f32x4 (&acc)[2][2][4][2], const Unit& u, int wr, int wc, int fr, int fq) const {
        const int row0 = u.pm * BM + wr * 64 + fr, col0 = u.pn * BM + wc * 32 + 8 * fq;
        u32x4 hv[2][4][2];
#define ER_LOAD(ai, m) do { _Pragma("unroll") for (int bj = 0; bj < 2; ++bj) hv[ai][m][bj] = *(const u32x4*)(Hh + (size_t)(row0 + (ai) * HALF + (m) * 16) * D + col0 + bj * HALF); } while (0)
#define ER_ROW(ai, m) do { const int row = row0 + (ai) * HALF + (m) * 16; bf16_t* hp = Hh + (size_t)row * D + col0; float sq = 0.f; \
            _Pragma("unroll") for (int bj = 0; bj < 2; ++bj) { f32x4 a, b; unpack8(hv[ai][m][bj], a, b); a += acc[ai][bj][m][0] * scale; b += acc[ai][bj][m][1] * scale; \
                sq += (a[0] * a[0] + a[1] * a[1]) + (a[2] * a[2] + a[3] * a[3]) + (b[0] * b[0] + b[1] * b[1]) + (b[2] * b[2] + b[3] * b[3]); \
                *(u32x4*)(hp + bj * HALF) = pack8(a, b); } \
            sq += __shfl_xor(sq, 16); sq += __shfl_xor(sq, 32); \
            if (fq == 0) atomicAdd(ssq_out + row, (unsigned)(sq * SSQ_FIX + 0.5f)); } while (0)
        ER_LOAD(0, 0); ER_LOAD(0, 1); ER_LOAD(0, 2); ER_LOAD(0, 3); ER_LOAD(1, 0); ER_LOAD(1, 1);
        asm volatile("" ::: "memory");
        ER_ROW(0, 0); ER_ROW(0, 1);
        asm volatile("" ::: "memory");
        ER_LOAD(1, 2); ER_LOAD(1, 3);
        asm volatile("" ::: "memory");
        ER_ROW(0, 2); ER_ROW(0, 3); ER_ROW(1, 0); ER_ROW(1, 1);
        asm volatile("" ::: "memory");
        ER_ROW(1, 2); ER_ROW(1, 3);
        asm volatile("" ::: "memory");
#undef ER_LOAD
#undef ER_ROW
        return false;
    }
};
struct EpiWin {
    static constexpr bool PERM = true, AFTER_DRAIN = false;
    bf16_t* qkv; bf16_t* glu; bf16_t* gA; bf16_t* gB; bf16_t* gC; const float* gbias; RowScale R; PG8_LAS unsigned char* lds;
    __device__ __forceinline__ void prefetch(const Unit& u, int wr, int lane) { R.prefetch(u, wr, lane); }
    __device__ __forceinline__ void stash(int wid, int lane) const { R.stash(lds, wid, lane); }
    __device__ __forceinline__ bool operator()(f32x4 (&acc)[2][2][4][2], const Unit& u, int wr, int wc, int fr, int fq) const {
        const int row0 = u.pm * BM + wr * 64 + fr, pn = u.pn;
        bf16_t* const pA = gA; bf16_t* const pB = gB; bf16_t* const pC = gC;
        float rs[2][4]; R.get(lds, wr * 4 + wc, fr, rs);
        if (pn < 12) {
            const int t = pn >> 1; const bool isq = (t == 0 || t == 3); const float sc = isq ? QSCALE : 1.f;
            const int bt = (u.pm * BM) / S; const int s0 = row0 - bt * S;
            bf16_t* base = qkv + (size_t)t * (64 * MiB / 2) + (isq ? (size_t)((pn & 1) * 256 + wc * 32 + 8 * fq) : ((size_t)(bt * NH + (pn & 1) * 4 + (wc >> 1)) * S) * HD + (wc & 1) * 32 + 8 * fq);
            const size_t rstride = isq ? (size_t)AW : (size_t)HD, bstride = isq ? (size_t)HALF : (size_t)2 * S * HD;
            const int rowq = isq ? row0 : s0;
#pragma unroll
            for (int ai = 0; ai < 2; ++ai)
#pragma unroll
                for (int m = 0; m < 4; ++m) { const float r = rs[ai][m] * sc; bf16_t* rp = base + (size_t)(rowq + ai * HALF + m * 16) * rstride;
#pragma unroll
                    for (int bj = 0; bj < 2; ++bj) st_nt(rp + bj * bstride, pack8(acc[ai][bj][m][0] * r, acc[ai][bj][m][1] * r)); }
        } else if (pn < 16) {
            bf16_t* base = glu + (pn - 12) * HALF + wc * 32 + 8 * fq;
#pragma unroll
            for (int ai = 0; ai < 2; ++ai)
#pragma unroll
                for (int m = 0; m < 4; ++m) { const float r = rs[ai][m]; f32x4 o[2];
#pragma unroll
                    for (int n = 0; n < 2; ++n) { const f32x4 a = acc[ai][0][m][n] * r, t = acc[ai][1][m][n] * (-LOG2E * r);
#pragma unroll
                        for (int k = 0; k < 4; ++k) o[n][k] = a[k] * rcpf_(1.f + ex2(t[k])); }
                    st_nt(base + (size_t)(row0 + ai * HALF + m * 16) * CC, pack8(o[0], o[1])); }
        } else {
            const int X = (pn - 16) >> 2, c0 = ((pn - 16) & 3) * 256 + wc * 32 + 8 * fq; bf16_t* base = pA; if (X == 1) base = pB; if (X == 2) base = pC; base += c0;
            f32x4 bv[2][2];
#pragma unroll
            for (int bj = 0; bj < 2; ++bj)
#pragma unroll
                for (int n = 0; n < 2; ++n) bv[bj][n] = *(const f32x4*)(gbias + X * D + c0 + bj * HALF + 4 * n) * (-LOG2E);
#pragma unroll
            for (int ai = 0; ai < 2; ++ai)
#pragma unroll
                for (int m = 0; m < 4; ++m) { const float c1 = -LOG2E * rs[ai][m]; bf16_t* rp = base + (size_t)(row0 + ai * HALF + m * 16) * D;
#pragma unroll
                    for (int bj = 0; bj < 2; ++bj) { f32x4 o[2];
#pragma unroll
                        for (int n = 0; n < 2; ++n) { const f32x4 t = acc[ai][bj][m][n] * c1 + bv[bj][n];
#pragma unroll
                            for (int k = 0; k < 4; ++k) o[n][k] = fmaxf(rcpf_(1.f + ex2(t[k])), 1e-18f); }
                        st_nt(rp + bj * HALF, pack8(o[0], o[1])); } }
        }
        return false;
    }
};
struct EpiMix {
    static constexpr bool PERM = true, AFTER_DRAIN = false;
    const bf16_t* gA; const bf16_t* gB; const bf16_t* gC; bf16_t* mixed;
    __device__ __forceinline__ void prefetch(const Unit&, int, int) {}
    __device__ __forceinline__ void stash(int, int) const {}
    __device__ __forceinline__ bool operator()(f32x4 (&acc)[2][2][4][2], const Unit& u, int wr, int wc, int fr, int fq) const {
        const int X = u.pn >> 2, pn = u.pn & 3, pm = u.pm - 768 * X;
        const bf16_t* const pA = gA; const bf16_t* const pB = gB; const bf16_t* const pC = gC;
        const int row0 = pm * BM + wr * 64 + fr, col0 = pn * BM + wc * 32 + 8 * fq;
        if (X < 2) {
            const bf16_t* g1 = pA; const bf16_t* g2 = pB; if (X == 1) { g1 = pB; g2 = pC; }
#pragma unroll
            for (int ai = 0; ai < 2; ++ai) {
                u32x4 nv[4][2], dv[4][2];
#pragma unroll
                for (int m = 0; m < 4; ++m)
#pragma unroll
                    for (int bj = 0; bj < 2; ++bj) { const size_t off = (size_t)(row0 + ai * HALF + m * 16) * D + col0 + bj * HALF; nv[m][bj] = *(const u32x4*)(g1 + off); dv[m][bj] = *(const u32x4*)(g2 + off); }
                asm volatile("" ::: "memory");
#pragma unroll
                for (int m = 0; m < 4; ++m)
#pragma unroll
                    for (int bj = 0; bj < 2; ++bj) { f32x4 n0, n1, d0, d1; unpack8(nv[m][bj], n0, n1); unpack8(dv[m][bj], d0, d1);
#pragma unroll
                        for (int k = 0; k < 4; ++k) { acc[ai][bj][m][0][k] *= n0[k] * rcpf_(d0[k]); acc[ai][bj][m][1][k] *= n1[k] * rcpf_(d1[k]); } }
            }
            return true;
        }
        u32x4 cv[2][4][2];
#pragma unroll
        for (int ai = 0; ai < 2; ++ai)
#pragma unroll
            for (int m = 0; m < 4; ++m)
#pragma unroll
                for (int bj = 0; bj < 2; ++bj) cv[ai][m][bj] = *(const u32x4*)(pC + (size_t)(row0 + ai * HALF + m * 16) * D + col0 + bj * HALF);
        asm volatile("" ::: "memory");
#pragma unroll
        for (int ai = 0; ai < 2; ++ai) {
#pragma unroll
            for (int m = 0; m < 4; ++m) { const size_t off = (size_t)(row0 + ai * HALF + m * 16) * D + col0;
#pragma unroll
                for (int bj = 0; bj < 2; ++bj) { f32x4 c0, c1; unpack8(cv[ai][m][bj], c0, c1);
                    *(u32x4*)(mixed + off + bj * HALF) = pack8(acc[ai][bj][m][0] * c0, acc[ai][bj][m][1] * c1); } }
            asm volatile("" ::: "memory");
        }
        return false;
    }
};
struct MixOrder {
    StaticOrder base;
    __device__ __forceinline__ bool next(int i, Unit& u) const { const int j = i / 3, X = i - 3 * j; Unit t; if (!base.next(j, t)) return false; u.pm = t.pm + 768 * X; u.pn = t.pn + 4 * X; return true; }
    __device__ __forceinline__ void a_ready(const Unit&) const {}
    __device__ __forceinline__ void done(const Unit&) const {}
};

template <class Epi, class Sched, bool ALIGN_EPI = false, bool SP2 = false>
__device__ __forceinline__ void gemm_phase(PG8_LAS unsigned char* lds, const Gemm g, const Sched& S, Epi& E) {
    int tid_ = threadIdx.x; asm volatile("" : "+v"(tid_));
    const int tid = tid_, wid = __builtin_amdgcn_readfirstlane(tid >> 6), lane = tid & 63, wr = wid >> 2, wc = wid & 3, fr = lane & 15, fq = lane >> 4;
    const int K = g.K, nt = K / BK;
    unsigned voffA[2], voffB[2];
#pragma unroll
    for (int i = 0; i < 2; ++i) { int R, C; stage_rc(tid * 16 + i * 8192, R, C); const int Rb = Epi::PERM ? ((R & ~31) + perm32(R & 31)) : R;
        voffA[i] = (unsigned)(R * K + C) * 2u; voffB[i] = (unsigned)(Rb * K + C) * 2u; }
    const size_t kstep = (size_t)(BK * 2);
    const size_t hstep = (size_t)HALF * K * 2;
    const size_t tstep = 2 * hstep;
    const unsigned ldsw = (unsigned)wid * 1024u;
    const int aoff = lds_byte(wr * 64 + fr, fq * 8), boff = lds_byte(wc * 32 + fr, fq * 8);
#define PG8_SA(b, h) (((b) * 2 + (h)) * HTB)
#define PG8_SB(b, h) ((4 + (b) * 2 + (h)) * HTB)
#define PG8_STAGE(bufoff, gbase, voff) do { _Pragma("unroll") for (int _i = 0; _i < 2; ++_i) \
        __builtin_amdgcn_global_load_lds((const unsigned*)((const char*)(gbase) + (voff)[_i]), (PG8_LAS unsigned*)(lds + (bufoff) + ldsw + _i * 8192), 16, 0, 0); } while (0)
#define PG8_LDA(dst, b, h) do { _Pragma("unroll") for (int m = 0; m < 4; ++m) _Pragma("unroll") for (int k = 0; k < 2; ++k) dst[m][k] = *(const PG8_LAS bf16x8*)(lds + PG8_SA(b, h) + aoff + m * 2048 + k * 1024); } while (0)
#define PG8_LDB(dst, b, h) do { _Pragma("unroll") for (int n = 0; n < 2; ++n) _Pragma("unroll") for (int k = 0; k < 2; ++k) dst[n][k] = *(const PG8_LAS bf16x8*)(lds + PG8_SB(b, h) + boff + n * 2048 + k * 1024); } while (0)
#define PG8_MMA(ai, bj, At, Bt) do { __builtin_amdgcn_s_setprio(1); _Pragma("unroll") for (int m = 0; m < 4; ++m) _Pragma("unroll") for (int n = 0; n < 2; ++n) _Pragma("unroll") for (int k = 0; k < 2; ++k) \
        acc[ai][bj][m][n] = __builtin_amdgcn_mfma_f32_16x16x32_bf16(Bt[n][k], At[m][k], acc[ai][bj][m][n], 0, 0, 0); __builtin_amdgcn_s_setprio(0); } while (0)
#define PG8_WAIT_V(n) asm volatile("s_waitcnt vmcnt(" #n ")" ::: "memory")
#define PG8_WAIT_L(n) asm volatile("s_waitcnt lgkmcnt(" #n ")" ::: "memory")
#define PG8_BAR __builtin_amdgcn_s_barrier()
#define PG8_SCHED __builtin_amdgcn_sched_barrier(0)
    Unit cur, nxt; int ui = 0;
    if (!S.next(0, cur)) return;
    f32x4 acc[2][2][4][2];
#pragma unroll
    for (int a = 0; a < 2; ++a)
#pragma unroll
        for (int b = 0; b < 2; ++b)
#pragma unroll
            for (int m = 0; m < 4; ++m)
#pragma unroll
                for (int n = 0; n < 2; ++n) acc[a][b][m][n] = (f32x4){0.f, 0.f, 0.f, 0.f};
    bf16x8 At[4][2], B0[2][2], B1[2][2];
    const char* cA = (const char*)g.A + (size_t)cur.pm * tstep; const char* cB = (const char*)g.Bt + (size_t)cur.pn * tstep;
    S.a_ready(cur); E.prefetch(cur, wr, lane);
    if constexpr (SP2) {
        PG8_STAGE(PG8_SB(0, 0), cB, voffB); PG8_STAGE(PG8_SB(0, 1), cB + hstep, voffB); PG8_STAGE(PG8_SA(0, 0), cA, voffA); PG8_STAGE(PG8_SA(0, 1), cA + hstep, voffA);
        if (wr == 1) PG8_BAR;
        PG8_WAIT_V(2); PG8_BAR;
        PG8_STAGE(PG8_SB(1, 0), cB + kstep, voffB); PG8_STAGE(PG8_SA(1, 0), cA + kstep, voffA); PG8_STAGE(PG8_SB(1, 1), cB + hstep + kstep, voffB);
        PG8_WAIT_V(6); PG8_BAR;
    } else {
        PG8_STAGE(PG8_SB(0, 0), cB, voffB); PG8_STAGE(PG8_SA(0, 0), cA, voffA); PG8_STAGE(PG8_SB(0, 1), cB + hstep, voffB); PG8_STAGE(PG8_SA(0, 1), cA + hstep, voffA);
        if (wr == 1) PG8_BAR;
        PG8_WAIT_V(4); PG8_BAR;
        PG8_STAGE(PG8_SB(1, 0), cB + kstep, voffB); PG8_STAGE(PG8_SA(1, 0), cA + kstep, voffA); PG8_STAGE(PG8_SB(1, 1), cB + hstep + kstep, voffB);
        PG8_WAIT_V(6); PG8_BAR;
    }
    for (;;) {
        const bool has_next = S.next(ui + 1, nxt);
        const char* nA = has_next ? (const char*)g.A + (size_t)nxt.pm * tstep : cA; const char* nB = has_next ? (const char*)g.Bt + (size_t)nxt.pn * tstep : cB;
        for (int t = 0; t < nt; t += 2) {
            const bool last = (t == nt - 2);
            const char* a1 = cA + (size_t)(t + 1) * kstep;
            const char* a2 = last ? nA : cA + (size_t)(t + 2) * kstep; const char* b2 = last ? nB : cB + (size_t)(t + 2) * kstep;
            const char* a3 = a2 + kstep; const char* b3 = b2 + kstep;
            if (last) { E.stash(wid, lane); if (has_next) { S.a_ready(nxt); E.prefetch(nxt, wr, lane); } }
            if constexpr (SP2) {
            PG8_LDB(B0, 0, 0); PG8_LDB(B1, 0, 1); PG8_SCHED; PG8_LDA(At, 0, 0); PG8_STAGE(PG8_SA(1, 1), a1 + hstep, voffA);
            PG8_WAIT_V(8); PG8_WAIT_L(0); PG8_BAR; PG8_MMA(0, 0, At, B0); PG8_MMA(0, 1, At, B1); PG8_BAR; PG8_SCHED;
            PG8_LDA(At, 0, 1); PG8_STAGE(PG8_SB(0, 0), b2, voffB); PG8_STAGE(PG8_SB(0, 1), b2 + hstep, voffB); PG8_STAGE(PG8_SA(0, 0), a2, voffA);
            PG8_WAIT_V(8); PG8_WAIT_L(0); PG8_BAR; PG8_MMA(1, 0, At, B0); PG8_MMA(1, 1, At, B1); PG8_BAR; PG8_SCHED;
            PG8_LDB(B0, 1, 0); PG8_LDB(B1, 1, 1); PG8_SCHED; PG8_LDA(At, 1, 0); PG8_STAGE(PG8_SA(0, 1), a2 + hstep, voffA);
            PG8_WAIT_V(8); PG8_WAIT_L(0); PG8_BAR; PG8_MMA(0, 0, At, B0); PG8_MMA(0, 1, At, B1); PG8_BAR; PG8_SCHED;
            PG8_LDA(At, 1, 1); PG8_STAGE(PG8_SB(1, 0), b3, voffB); PG8_STAGE(PG8_SB(1, 1), b3 + hstep, voffB); PG8_STAGE(PG8_SA(1, 0), a3, voffA);
            PG8_WAIT_V(8); PG8_WAIT_L(0); PG8_BAR; PG8_MMA(1, 0, At, B0); PG8_MMA(1, 1, At, B1); PG8_BAR; PG8_SCHED;
            } else {
            PG8_LDB(B0, 0, 0); PG8_SCHED; PG8_LDA(At, 0, 0); PG8_STAGE(PG8_SA(1, 1), a1 + hstep, voffA);
            PG8_WAIT_L(8); PG8_BAR; PG8_WAIT_L(0); PG8_MMA(0, 0, At, B0); PG8_BAR; PG8_SCHED;
            PG8_LDB(B1, 0, 1); PG8_STAGE(PG8_SB(0, 0), b2, voffB);
            PG8_BAR; PG8_WAIT_L(0); PG8_MMA(0, 1, At, B1); PG8_BAR;
            PG8_LDA(At, 0, 1); PG8_STAGE(PG8_SA(0, 0), a2, voffA);
            PG8_BAR; PG8_WAIT_L(0); PG8_MMA(1, 0, At, B0); PG8_BAR; PG8_SCHED;
            PG8_STAGE(PG8_SB(0, 1), b2 + hstep, voffB);
            PG8_WAIT_V(6); PG8_BAR; PG8_MMA(1, 1, At, B1); PG8_BAR;
            PG8_LDB(B0, 1, 0); PG8_SCHED; PG8_LDA(At, 1, 0); PG8_STAGE(PG8_SA(0, 1), a2 + hstep, voffA);
            PG8_WAIT_L(8); PG8_BAR; PG8_WAIT_L(0); PG8_MMA(0, 0, At, B0); PG8_BAR; PG8_SCHED;
            PG8_LDB(B1, 1, 1); PG8_STAGE(PG8_SB(1, 0), b3, voffB);
            PG8_BAR; PG8_WAIT_L(0); PG8_MMA(0, 1, At, B1); PG8_BAR;
            PG8_LDA(At, 1, 1); PG8_STAGE(PG8_SA(1, 0), a3, voffA);
            PG8_BAR; PG8_WAIT_L(0); PG8_MMA(1, 0, At, B0); PG8_BAR; PG8_SCHED;
            PG8_STAGE(PG8_SB(1, 1), b3 + hstep, voffB);
            PG8_WAIT_V(6); PG8_BAR; PG8_MMA(1, 1, At, B1); PG8_BAR;
            }
        }
        if constexpr (ALIGN_EPI) { if (wr == 0) PG8_BAR; }
        bool keep = false;
        if constexpr (!Epi::AFTER_DRAIN) { keep = E(acc, cur, wr, wc, fr, fq); S.done(cur); }
        if (!has_next) break;
        if (!keep) {
#pragma unroll
        for (int a = 0; a < 2; ++a)
#pragma unroll
            for (int b = 0; b < 2; ++b)
#pragma unroll
                for (int m = 0; m < 4; ++m)
#pragma unroll
                    for (int n = 0; n < 2; ++n) acc[a][b][m][n] = (f32x4){0.f, 0.f, 0.f, 0.f};
        }
        cur = nxt; cA = nA; cB = nB; ++ui;
        if constexpr (ALIGN_EPI) { if (wr == 1) PG8_BAR; }
    }
    PG8_WAIT_V(0);
    if constexpr (!ALIGN_EPI) { if (wr == 0) PG8_BAR; }
    PG8_BAR;
    if constexpr (Epi::AFTER_DRAIN) { E.fused(acc, cur, wr, wc, fr, fq, lds, wid, lane); S.done(cur); }
#undef PG8_SA
#undef PG8_SB
#undef PG8_STAGE
#undef PG8_LDA
#undef PG8_LDB
#undef PG8_MMA
#undef PG8_WAIT_V
#undef PG8_WAIT_L
#undef PG8_BAR
#undef PG8_SCHED
}
}

namespace att {
#define LAS3 __attribute__((address_space(3)))
typedef unsigned short bf16_t;
typedef short bf16x8 __attribute__((ext_vector_type(8)));
typedef short s16x4 __attribute__((ext_vector_type(4)));
typedef float f32x16 __attribute__((ext_vector_type(16)));
typedef float f32x4 __attribute__((ext_vector_type(4)));
typedef unsigned u32x4 __attribute__((ext_vector_type(4)));
constexpr int SLOTB = 8192;
constexpr int L_WS = 0, L_KM = 2048, L_KMX = L_KM + 16384, L_FLG = L_KMX + 64, L_RING = 19456, L_K = L_RING, L_V4 = L_RING + 4 * SLOTB, L_OST = L_RING + 8 * SLOTB, L_K3 = L_RING, L_V3 = L_RING + 6 * SLOTB, L_RED = L_RING, L_END = L_RING + 12 * SLOTB;
static_assert(L_FLG + 64 <= L_RING && L_END <= 131072 && L_OST + 8 * 4096 <= L_END, "mixer LDS map");
constexpr float SB_EXIT = 40.f;
constexpr int L_CONV = 0;
__device__ __forceinline__ int crow(int r, int hi) { return (r & 3) + 8 * (r >> 2) + 4 * hi; }
__device__ __forceinline__ float ex2(float x) { return __builtin_amdgcn_exp2f(x); }
__device__ __forceinline__ float min80(float x) { return __builtin_amdgcn_fmed3f(x, 80.f, -3.0e38f); }
__device__ __forceinline__ float lg2(float x) { return __builtin_amdgcn_logf(x); }
__device__ __forceinline__ unsigned cvtpk(float lo, float hi) { unsigned r; asm volatile("v_cvt_pk_bf16_f32 %0, %1, %2" : "=v"(r) : "v"(lo), "v"(hi)); return r; }
__device__ __forceinline__ float bf2f(bf16_t v) { return __uint_as_float((unsigned)v << 16); }
__device__ __forceinline__ void glds16(const void* gsrc, unsigned lds_dst) { unsigned keep;
    asm volatile("s_mov_b32 %0, m0\n\ts_mov_b32 m0, %2\n\ts_nop 0\n\tglobal_load_lds_dwordx4 %1, off\n\ts_mov_b32 m0, %0" : "=&s"(keep) : "v"(gsrc), "s"(lds_dst) : "memory"); }
__device__ __forceinline__ void glds16s(const void* sbase, unsigned voff, unsigned lds_dst) { unsigned keep;
    asm volatile("s_mov_b32 %0, m0\n\ts_mov_b32 m0, %3\n\ts_nop 0\n\tglobal_load_lds_dwordx4 %1, %2\n\ts_mov_b32 m0, %0" : "=&s"(keep) : "v"(voff), "s"(sbase), "s"(lds_dst) : "memory"); }
__device__ __forceinline__ const void* uni_ptr(const void* p) { const unsigned long long a = (unsigned long long)(uintptr_t)p;
    const unsigned lo = (unsigned)__builtin_amdgcn_readfirstlane((int)(unsigned)a), hi = (unsigned)__builtin_amdgcn_readfirstlane((int)(unsigned)(a >> 32)); return (const void*)(uintptr_t)(((unsigned long long)hi << 32) | lo); }
#define ATT_WAIT_BAR() asm volatile("s_waitcnt vmcnt(0) lgkmcnt(0)\n\ts_barrier" ::: "memory")
__device__ __forceinline__ void qkt(f32x16& p0, f32x16& p1, const LAS3 unsigned char* Kslot, const bf16x8* qr, const f32x16& cin, int r32, int hi) {
    const LAS3 unsigned char* kb = Kslot + r32 * 128; const int sw = (r32 >> 1) & 7;
#pragma unroll
    for (int d0 = 0; d0 < 4; ++d0) {
        const int ko = ((2 * d0 + hi) ^ sw) << 4;
        const bf16x8 b0 = *(const LAS3 bf16x8*)(kb + ko);
        const bf16x8 b1 = *(const LAS3 bf16x8*)(kb + ko + 4096);
        if (d0 == 0) { p0 = __builtin_amdgcn_mfma_f32_32x32x16_bf16(b0, qr[0], cin, 0, 0, 0); p1 = __builtin_amdgcn_mfma_f32_32x32x16_bf16(b1, qr[0], cin, 0, 0, 0); }
        else { p0 = __builtin_amdgcn_mfma_f32_32x32x16_bf16(b0, qr[d0], p0, 0, 0, 0); p1 = __builtin_amdgcn_mfma_f32_32x32x16_bf16(b1, qr[d0], p1, 0, 0, 0); } }
}
__device__ __forceinline__ void pv(f32x16* o, int vb, bf16x8 pa0, bf16x8 pa1, bf16x8 pa2, bf16x8 pa3) {
#pragma unroll
    for (int d0 = 0; d0 < 2; ++d0) { s16x4 lo[4], hi[4];
#pragma unroll
        for (int ks = 0; ks < 4; ++ks) {
            asm volatile("ds_read_b64_tr_b16 %0,%1 offset:%c2" : "=&v"(lo[ks]) : "v"(vb), "i"(d0 * 4096 + ks * 1024) : "memory");
            asm volatile("ds_read_b64_tr_b16 %0,%1 offset:%c2" : "=&v"(hi[ks]) : "v"(vb), "i"(d0 * 4096 + ks * 1024 + 512) : "memory"); }
        asm volatile("s_waitcnt lgkmcnt(0)" ::: "memory"); __builtin_amdgcn_sched_barrier(0);
#define ATT_PK(k) (bf16x8){lo[k][0], lo[k][1], lo[k][2], lo[k][3], hi[k][0], hi[k][1], hi[k][2], hi[k][3]}
        o[d0] = __builtin_amdgcn_mfma_f32_32x32x16_bf16(pa0, ATT_PK(0), o[d0], 0, 0, 0);
        o[d0] = __builtin_amdgcn_mfma_f32_32x32x16_bf16(pa1, ATT_PK(1), o[d0], 0, 0, 0);
        o[d0] = __builtin_amdgcn_mfma_f32_32x32x16_bf16(pa2, ATT_PK(2), o[d0], 0, 0, 0);
        o[d0] = __builtin_amdgcn_mfma_f32_32x32x16_bf16(pa3, ATT_PK(3), o[d0], 0, 0, 0);
#undef ATT_PK
    }
}
__device__ __forceinline__ unsigned cvtpk_nv(float lo, float hi) { unsigned r; asm("v_cvt_pk_bf16_f32 %0, %1, %2" : "=v"(r) : "v"(lo), "v"(hi)); return r; }
__device__ __forceinline__ bf16x8 pack8n(const f32x16& p, int b) { u32x4 w; w.x = cvtpk_nv(p[b], p[b + 1]); w.y = cvtpk_nv(p[b + 2], p[b + 3]); w.z = cvtpk_nv(p[b + 4], p[b + 5]); w.w = cvtpk_nv(p[b + 6], p[b + 7]); return __builtin_bit_cast(bf16x8, w); }
__device__ __forceinline__ bf16x8 pack8(const f32x16& p, int b) { u32x4 w; w.x = cvtpk(p[b], p[b + 1]); w.y = cvtpk(p[b + 2], p[b + 3]); w.z = cvtpk(p[b + 4], p[b + 5]); w.w = cvtpk(p[b + 6], p[b + 7]); return __builtin_bit_cast(bf16x8, w); }
__device__ __forceinline__ void store_o(const f32x16* o, const float* rli, bf16_t* Ow, LAS3 unsigned char* shm, int ost, int wid, int lane, int r32, int hi) {
    LAS3 bf16_t* stg = (LAS3 bf16_t*)(shm + ost) + wid * 2048;
#pragma unroll
    for (int r = 0; r < 16; ++r) { const int orow = crow(r, hi);
#pragma unroll
        for (int d0 = 0; d0 < 2; ++d0) stg[orow * 64 + d0 * 32 + r32] = (bf16_t)(cvtpk(o[d0][r] * rli[r], 0.f) & 0xffffu); }
    asm volatile("s_waitcnt lgkmcnt(0)" ::: "memory");
#pragma unroll
    for (int i = 0; i < 4; ++i) { const int row = i * 8 + (lane >> 3), ch = lane & 7; const u32x4 v = *(const LAS3 u32x4*)(stg + row * 64 + ch * 8); *(u32x4*)(Ow + (size_t)row * AW + ch * 8) = v; }
}

__device__ __forceinline__ void sb_units(int b, int h, const bf16_t* Q, const bf16_t* __restrict__ K, const bf16_t* __restrict__ V, bf16_t* O, LAS3 unsigned char* shm) {
    int tid_ = threadIdx.x; asm volatile("" : "+v"(tid_)); const int tid = tid_, lane = tid & 63, r32 = lane & 31, hi = lane >> 5; const int wid = __builtin_amdgcn_readfirstlane(tid >> 6);
    const size_t rowbase = (size_t)b * S;
    const bf16_t* Kh = K + ((size_t)(b * NH + h) * S) * HD; const bf16_t* Vh = V + ((size_t)(b * NH + h) * S) * HD;
    const unsigned lds0 = (unsigned)(uintptr_t)shm;
    const int krow = 8 * wid + (lane >> 3); const bf16_t* ksrc = Kh + (size_t)krow * HD + (((lane & 7) ^ ((krow >> 1) & 7)) * 8);
    const bf16_t* vsrc = Vh + (size_t)(16 * (wid & 3) + (lane >> 2)) * HD + (wid >> 2) * 32 + (lane & 3) * 8;
    const unsigned kdst = lds0 + L_K + wid * 1024, vdst = lds0 + L_V4 + wid * 1024;
    const int vb0 = (int)(lds0 + L_V4) + ((lane >> 4) & 1) * 32 + (lane & 3) * 8 + (4 * hi + ((lane & 15) >> 2)) * 64;
#define SB_DMA(t, slot) do { glds16(ksrc + (size_t)(t) * 64 * HD, (unsigned)__builtin_amdgcn_readfirstlane(kdst + (slot) * SLOTB)); glds16(vsrc + (size_t)(t) * 64 * HD, (unsigned)__builtin_amdgcn_readfirstlane(vdst + (slot) * SLOTB)); } while (0)
#pragma unroll
    for (int pre = 0; pre < 3; ++pre) SB_DMA(3 - pre, pre);
    bf16x8 qr[4];
#pragma unroll
    for (int d0 = 0; d0 < 4; ++d0) qr[d0] = *(const bf16x8*)(Q + (rowbase + wid * 32 + r32) * AW + h * HD + d0 * 16 + hi * 8);
    bf16x8 TA0, TA1, ONES;
#pragma unroll
    for (int j = 0; j < 8; ++j) { const int kk = (j & 3) + 8 * (j >> 2) + 4 * hi; TA0[j] = (kk > r32) ? (short)0xBF80 : (short)0; TA1[j] = (kk + 16 > r32) ? (short)0xBF80 : (short)0; ONES[j] = (short)0xBF80; }
    const f32x16 zero16 = f32x16{};
    const int qrel = wid * 32 + r32;
    if (wid >= 4) __builtin_amdgcn_s_setprio(1);
  for (int qb = 0; qb < 8; ++qb) {
    const int q0 = qb * 256, NT = 4 * qb + 4;
    f32x16 o[2]; o[0] = f32x16{}; o[1] = f32x16{};
    float C = 0.f;
    volatile LAS3 unsigned* flg = (volatile LAS3 unsigned*)(shm + L_FLG);
    bool wdone = false;
    for (int it = 0; it < NT; ++it) {
        const int t = NT - 1 - it, slot = it & 3;
        { const int younger = (NT - 1 - it < 2 ? NT - 1 - it : 2);
          if (younger == 2) asm volatile("s_waitcnt vmcnt(4) lgkmcnt(0)\n\ts_barrier" ::: "memory");
          else if (younger == 1) asm volatile("s_waitcnt vmcnt(2) lgkmcnt(0)\n\ts_barrier" ::: "memory");
          else ATT_WAIT_BAR(); }
        if (it > 0) { const LAS3 u32x4* f = (const LAS3 u32x4*)((LAS3 unsigned*)flg + ((it - 1) & 1) * 8); const u32x4 fa_ = f[0], fb_ = f[1]; const unsigned all = (fa_.x & fa_.y) & (fa_.z & fa_.w) & (fb_.x & fb_.y) & (fb_.z & fb_.w); if (__builtin_amdgcn_readfirstlane(all)) break; }
        if (it + 3 < NT) SB_DMA(t - 3, (it + 3) & 3);
        const int jb = t - 4 * qb;
        const bool active = !wdone && ((jb < 0) || (64 * jb < 32 * wid + 31));
        if (active) {
            f32x16 p0, p1, s0, s1;
            qkt(p0, p1, shm + L_K + slot * SLOTB, qr, zero16, r32, hi);
#pragma unroll
            for (int r = 0; r < 16; ++r) { p0[r] = min80(p0[r]); p1[r] = min80(p1[r]); s0[r] = lg2(1.f + ex2(p0[r])); s1[r] = lg2(1.f + ex2(p1[r])); }
            if (jb >= 0 && 32 * wid < 64 * jb + 64) {
#pragma unroll
                for (int r = 0; r < 16; ++r) { const int kv = 64 * jb + crow(r, hi);
                    if (kv >= qrel) { s0[r] = 0.f; p0[r] = -INFINITY; } if (kv + 32 >= qrel) { s1[r] = 0.f; p1[r] = -INFINITY; } }
            }
            const bf16x8 B0 = pack8(s0, 0), B1 = pack8(s0, 8), B2 = pack8(s1, 0), B3 = pack8(s1, 8);
            f32x16 cin;
#pragma unroll
            for (int r = 0; r < 16; ++r) cin[r] = C;
            f32x16 x0 = __builtin_amdgcn_mfma_f32_32x32x16_bf16(TA0, B0, cin, 0, 0, 0);
            x0 = __builtin_amdgcn_mfma_f32_32x32x16_bf16(TA1, B1, x0, 0, 0, 0);
            x0 = __builtin_amdgcn_mfma_f32_32x32x16_bf16(ONES, B2, x0, 0, 0, 0);
            x0 = __builtin_amdgcn_mfma_f32_32x32x16_bf16(ONES, B3, x0, 0, 0, 0);
            f32x16 x1 = __builtin_amdgcn_mfma_f32_32x32x16_bf16(TA0, B2, cin, 0, 0, 0);
            x1 = __builtin_amdgcn_mfma_f32_32x32x16_bf16(TA1, B3, x1, 0, 0, 0);
            const float cnew = x0[0] - s0[0];
            C = __shfl(cnew, r32);
#pragma unroll
            for (int r = 0; r < 16; ++r) { p0[r] = ex2(p0[r] - s0[r] + x0[r]); p1[r] = ex2(p1[r] - s1[r] + x1[r]); }
            pv(o, vb0 + slot * SLOTB, pack8(p0, 0), pack8(p0, 8), pack8(p1, 0), pack8(p1, 8));
        }
        { const bool done = __builtin_amdgcn_ballot_w64(C > -SB_EXIT) == 0ull; wdone = done; if (lane == 0) flg[(it & 1) * 8 + wid] = done ? 1u : 0u; }
    }
    ATT_WAIT_BAR();
    bf16x8 qn[4];
    if (qb < 7) {
#pragma unroll
        for (int pre = 0; pre < 3; ++pre) SB_DMA(NT + 3 - pre, pre);
#pragma unroll
        for (int d0 = 0; d0 < 4; ++d0) qn[d0] = *(const bf16x8*)(Q + (rowbase + q0 + 256 + wid * 32 + r32) * AW + h * HD + d0 * 16 + hi * 8);
    }
    float rli[16];
#pragma unroll
    for (int r = 0; r < 16; ++r) rli[r] = 1.f;
    store_o(o, rli, O + (rowbase + q0 + wid * 32) * AW + h * HD, shm, L_OST, wid, lane, r32, hi);
    if (qb < 7) {
#pragma unroll
        for (int d0 = 0; d0 < 4; ++d0) qr[d0] = qn[d0]; }
  }
    __builtin_amdgcn_s_setprio(0);
    ATT_WAIT_BAR();
#undef SB_DMA
}

constexpr float MB_EXIT = 51.f, MB_REF = 45.f;
__device__ __forceinline__ void moba_units(int b, int jdeal, const bf16_t* Q, const bf16_t* __restrict__ K, const bf16_t* __restrict__ V, bf16_t* O, LAS3 unsigned char* shm) {
    int tid_ = threadIdx.x; asm volatile("" : "+v"(tid_)); const int tid = tid_, lane = tid & 63, r32 = lane & 31, hi = lane >> 5; const int wid = __builtin_amdgcn_readfirstlane(tid >> 6);
    const size_t rowbase = (size_t)b * S;
    const unsigned lds0 = (unsigned)(uintptr_t)shm;
    const int krow = 8 * wid + (lane >> 3);
    const bf16_t* ksrc0 = K + ((size_t)b * NH * S) * HD; const bf16_t* vsrc0 = V + ((size_t)b * NH * S) * HD;
    const unsigned koff = (unsigned)(krow * HD + (((lane & 7) ^ ((krow >> 1) & 7)) * 8)) * 2u;
    const unsigned voff = (unsigned)((16 * (wid & 3) + (lane >> 2)) * HD + (wid >> 2) * 32 + (lane & 3) * 8) * 2u;
    const unsigned kdst = lds0 + L_K3 + wid * 1024, vdst = lds0 + L_V3 + wid * 1024;
    const int vb0 = (int)(lds0 + L_V3) + ((lane >> 4) & 1) * 32 + (lane & 3) * 8 + (4 * hi + ((lane & 15) >> 2)) * 64;
#define MB_DMA2(ksrc, vsrc, dt, slot) do { const void* kb_ = uni_ptr(ksrc + (size_t)(2 * (dt)) * 64 * HD); const void* vb_ = uni_ptr(vsrc + (size_t)(2 * (dt)) * 64 * HD); \
        glds16s(kb_, koff, (unsigned)__builtin_amdgcn_readfirstlane(kdst + (slot) * 2 * SLOTB)); glds16s(kb_, koff + 64 * HD * 2, (unsigned)__builtin_amdgcn_readfirstlane(kdst + (slot) * 2 * SLOTB + SLOTB)); \
        glds16s(vb_, voff, (unsigned)__builtin_amdgcn_readfirstlane(vdst + (slot) * 2 * SLOTB)); glds16s(vb_, voff + 64 * HD * 2, (unsigned)__builtin_amdgcn_readfirstlane(vdst + (slot) * 2 * SLOTB + SLOTB)); } while (0)
#define MB_OWN(i) ((i) < 4 ? (((i) & 1) ? ((jdeal + 2 * ((i) >> 1) + 2) & 7) : 7 - ((jdeal + 2 * ((i) >> 1) + 2) & 7)) : (((i) & 1) ? 7 - jdeal : jdeal))
#define MB_ASC(i) ((i) >= 4 && !((i) & 1))
    bf16x8 qr[4];
    const unsigned qoff = (unsigned)(r32 * AW + hi * 8) * 2u;
    { const int own0 = MB_OWN(0); MB_DMA2(ksrc0, vsrc0, 2 * own0 + 1, 0);
#pragma unroll
      for (int d0 = 0; d0 < 4; ++d0) qr[d0] = *(const bf16x8*)((const char*)(Q + (rowbase + own0 * 256 + wid * 32) * AW) + qoff + d0 * 32); }
    bf16x8 ONESA;
#pragma unroll
    for (int j = 0; j < 8; ++j) ONESA[j] = (short)0x3F80;
    if (wid >= 4) __builtin_amdgcn_s_setprio(1);
  for (int h = 0; h < 8; ++h) {
    const int own = MB_OWN(h), q0 = own * 256, ND = 2 * own + 2; const bool asc = MB_ASC(h);
#define ksrc (ksrc0 + (size_t)h * S * HD)
#define vsrc (vsrc0 + (size_t)h * S * HD)
    unsigned sel = 0u; float qn;
    {
        const LAS3 float* km = (const LAS3 float*)(shm + L_KM) + h * 512;
        float gsc[8]; float q2 = 0.f;
#pragma unroll
        for (int d0 = 0; d0 < 4; ++d0)
#pragma unroll
            for (int j = 0; j < 8; ++j) { const float qv = bf2f((bf16_t)qr[d0][j]); q2 += qv * qv; }
        q2 += __shfl_xor(q2, 32); qn = __builtin_sqrtf(q2) * 1.0001f;
#pragma unroll
        for (int pb = 0; pb < 7; ++pb) { float s = -INFINITY;
            if (pb < own) { s = 0.f;
#pragma unroll
                for (int d0 = 0; d0 < 4; ++d0)
#pragma unroll
                    for (int j = 0; j < 8; ++j) s += bf2f((bf16_t)qr[d0][j]) * km[pb * 64 + d0 * 16 + hi * 8 + j];
                s += __shfl_xor(s, 32); }
            gsc[pb] = s; }
        gsc[7] = -INFINITY;
#pragma unroll
        for (int it = 0; it < 3; ++it) { int best = -1; float bv = -INFINITY;
#pragma unroll
            for (int pb = 0; pb < 8; ++pb) { const bool c = !((sel >> pb) & 1u) && gsc[pb] > bv; bv = c ? gsc[pb] : bv; best = c ? pb : best; }
            if (best >= 0) sel |= 1u << best; }
    }
    const float kmax = ((const LAS3 float*)(shm + L_KMX))[h];
    const float slope2 = exp2f(-(float)(h + 1)) * LOG2E;
    const float d32 = 32.f * slope2, d64 = 64.f * slope2, d96 = 96.f * slope2;
    f32x16 o[2]; o[0] = f32x16{}; o[1] = f32x16{};
    float mrun = -1e30f, lrun = 0.f;
    f32x16 lvec = f32x16{};
    const float Bq = qn * kmax;
    const bool fast = __builtin_amdgcn_ballot_w64(!(Bq <= MB_REF)) == 0ull;
    LAS3 float* wsf = (LAS3 float*)(shm + L_WS) + wid * 64;
    volatile LAS3 unsigned* flg = (volatile LAS3 unsigned*)(shm + L_FLG);
    const int qrel = wid * 32 + r32;
    bool wdone = false; int s3 = 0;
    MB_DMA2(ksrc, vsrc, asc ? 1 : ND - 2, 1);
    if (fast) {
    for (int it = 0; it < ND; ++it) {
        const int dt = asc ? it : ND - 1 - it, slot = s3;
        if (it + 1 < ND) asm volatile("s_waitcnt vmcnt(4) lgkmcnt(0)\n\ts_barrier" ::: "memory");
        else ATT_WAIT_BAR();
        if (it > 0) { const LAS3 u32x4* f = (const LAS3 u32x4*)((LAS3 unsigned*)flg + ((it - 1) & 1) * 8); const u32x4 fa_ = f[0], fb_ = f[1]; const unsigned all = (fa_.x & fa_.y) & (fa_.z & fa_.w) & (fb_.x & fb_.y) & (fb_.z & fb_.w); if (__builtin_amdgcn_readfirstlane(all)) break; }
        if (it + 2 < ND) MB_DMA2(ksrc, vsrc, asc ? dt + 2 : dt - 2, (s3 == 0 ? 2 : s3 - 1));
        s3 = (s3 == 2) ? 0 : s3 + 1;
        const int pb = dt >> 1, jb = dt - 2 * own;
        const bool selme = (jb >= 0) || ((sel >> pb) & 1u);
        const bool active = !wdone && ((jb >= 0) ? (128 * jb <= 32 * wid + 31) : (__builtin_amdgcn_ballot_w64(selme) != 0ull));
        if (active && true) {
            const int istar = (jb >= 0) ? wid - 4 * jb : 4;
            const float basev = slope2 * (float)(128 * dt + 4 * hi - (q0 + qrel)) - Bq;
            const int kb = (int)(lds0 + L_K3) + slot * 2 * SLOTB + r32 * 128; const int ksw = (r32 >> 1) & 7;
            const int kbd[4] = {kb + (((0 + hi) ^ ksw) << 4), kb + (((2 + hi) ^ ksw) << 4), kb + (((4 + hi) ^ ksw) << 4), kb + (((6 + hi) ^ ksw) << 4)};
#define MB_KREAD(F, D0, OFF) asm volatile("ds_read_b128 %0,%1 offset:%c2" : "=&v"(F) : "v"(kbd[D0]), "i"(OFF) : "memory")
            bf16x8 fa[8], fb[8];
#pragma unroll
            for (int d0 = 0; d0 < 4; ++d0) { MB_KREAD(fa[2 * d0], d0, 0); MB_KREAD(fa[2 * d0 + 1], d0, 4096); }
            f32x16 p0, p1, p2, p3;
#define MB_CIN(P, I) do { const float bi_ = (selme && (I) <= istar) ? basev + (float)(I) * d32 : -INFINITY; \
                _Pragma("unroll") for (int r = 0; r < 16; ++r) P[r] = __builtin_fmaf(slope2, (float)((r & 3) + 8 * (r >> 2)), bi_); \
                if ((I) == istar) { _Pragma("unroll") for (int r = 0; r < 16; ++r) if (crow(r, hi) > r32) P[r] = -INFINITY; } } while (0)
            MB_CIN(p0, 0); MB_CIN(p1, 1); MB_CIN(p2, 2); MB_CIN(p3, 3);
#undef MB_CIN
            asm volatile("s_waitcnt lgkmcnt(0)" ::: "memory"); __builtin_amdgcn_sched_barrier(0);
#pragma unroll
            for (int d0 = 0; d0 < 4; ++d0) { MB_KREAD(fb[2 * d0], d0, SLOTB); MB_KREAD(fb[2 * d0 + 1], d0, SLOTB + 4096); }
            __builtin_amdgcn_sched_barrier(0);
#pragma unroll
            for (int d0 = 0; d0 < 4; ++d0) { p0 = __builtin_amdgcn_mfma_f32_32x32x16_bf16(fa[2 * d0], qr[d0], p0, 0, 0, 0); p1 = __builtin_amdgcn_mfma_f32_32x32x16_bf16(fa[2 * d0 + 1], qr[d0], p1, 0, 0, 0); }
            const int vb = vb0 + slot * 2 * SLOTB;
            s16x4 vlo[4], vhi[4], wlo[4], whi[4];
#define MB_VREADS(LO, HI, VB, D0) do { _Pragma("unroll") for (int ks = 0; ks < 4; ++ks) { \
                asm volatile("ds_read_b64_tr_b16 %0,%1 offset:%c2" : "=&v"(LO[ks]) : "v"(VB), "i"((D0) * 4096 + ks * 1024) : "memory"); \
                asm volatile("ds_read_b64_tr_b16 %0,%1 offset:%c2" : "=&v"(HI[ks]) : "v"(VB), "i"((D0) * 4096 + ks * 1024 + 512) : "memory"); } } while (0)
#define MB_LSUM(PA0, PA1, PA2, PA3) do { lvec = __builtin_amdgcn_mfma_f32_32x32x16_bf16(ONESA, PA0, lvec, 0, 0, 0); lvec = __builtin_amdgcn_mfma_f32_32x32x16_bf16(ONESA, PA1, lvec, 0, 0, 0); \
                lvec = __builtin_amdgcn_mfma_f32_32x32x16_bf16(ONESA, PA2, lvec, 0, 0, 0); lvec = __builtin_amdgcn_mfma_f32_32x32x16_bf16(ONESA, PA3, lvec, 0, 0, 0); } while (0)
#define MB_PK(LO, HI, k) (bf16x8){LO[k][0], LO[k][1], LO[k][2], LO[k][3], HI[k][0], HI[k][1], HI[k][2], HI[k][3]}
#define MB_PV(D0, LO, HI, PA0, PA1, PA2, PA3) do { \
                o[D0] = __builtin_amdgcn_mfma_f32_32x32x16_bf16(PA0, MB_PK(LO, HI, 0), o[D0], 0, 0, 0); o[D0] = __builtin_amdgcn_mfma_f32_32x32x16_bf16(PA1, MB_PK(LO, HI, 1), o[D0], 0, 0, 0); \
                o[D0] = __builtin_amdgcn_mfma_f32_32x32x16_bf16(PA2, MB_PK(LO, HI, 2), o[D0], 0, 0, 0); o[D0] = __builtin_amdgcn_mfma_f32_32x32x16_bf16(PA3, MB_PK(LO, HI, 3), o[D0], 0, 0, 0); } while (0)
            asm volatile("s_waitcnt lgkmcnt(0)" ::: "memory");
            MB_VREADS(vlo, vhi, vb, 0);
            __builtin_amdgcn_sched_barrier(0);
#pragma unroll
            for (int d0 = 0; d0 < 4; ++d0) { p2 = __builtin_amdgcn_mfma_f32_32x32x16_bf16(fb[2 * d0], qr[d0], p2, 0, 0, 0); p3 = __builtin_amdgcn_mfma_f32_32x32x16_bf16(fb[2 * d0 + 1], qr[d0], p3, 0, 0, 0); }
#pragma unroll
            for (int r = 0; r < 16; ++r) { p0[r] = ex2(p0[r]); p1[r] = ex2(p1[r]); }
            const bf16x8 a0 = pack8n(p0, 0), a1 = pack8n(p0, 8), a2 = pack8n(p1, 0), a3 = pack8n(p1, 8);
            __builtin_amdgcn_sched_barrier(0);
            asm volatile("s_waitcnt lgkmcnt(0)" ::: "memory");
            MB_VREADS(wlo, whi, vb, 1);
            __builtin_amdgcn_sched_barrier(0);
            MB_PV(0, vlo, vhi, a0, a1, a2, a3);
#pragma unroll
            for (int r = 0; r < 16; ++r) p2[r] = ex2(p2[r]);
            __builtin_amdgcn_sched_barrier(0);
            asm volatile("s_waitcnt lgkmcnt(0)" ::: "memory");
            MB_VREADS(vlo, vhi, vb + SLOTB, 0);
            __builtin_amdgcn_sched_barrier(0);
            MB_PV(1, wlo, whi, a0, a1, a2, a3);
            MB_LSUM(a0, a1, a2, a3);
#pragma unroll
            for (int r = 0; r < 16; ++r) p3[r] = ex2(p3[r]);
            const bf16x8 b0 = pack8n(p2, 0), b1 = pack8n(p2, 8), b2 = pack8n(p3, 0), b3 = pack8n(p3, 8);
            __builtin_amdgcn_sched_barrier(0);
            asm volatile("s_waitcnt lgkmcnt(0)" ::: "memory");
            MB_VREADS(wlo, whi, vb + SLOTB, 1);
            __builtin_amdgcn_sched_barrier(0);
            MB_PV(0, vlo, vhi, b0, b1, b2, b3);
            __builtin_amdgcn_sched_barrier(0);
            asm volatile("s_waitcnt lgkmcnt(0)" ::: "memory");
            __builtin_amdgcn_sched_barrier(0);
            MB_PV(1, wlo, whi, b0, b1, b2, b3);
            MB_LSUM(b0, b1, b2, b3);
#undef MB_PV
#undef MB_LSUM
#undef MB_PK
#undef MB_VREADS
#undef MB_KREAD
            mrun = Bq + lg2(lvec[0]);
        } else if (active) {
            f32x16 p0, p1, p2, p3, cin;
            const float base = selme ? slope2 * (float)(128 * dt + 4 * hi - (q0 + qrel)) : -INFINITY;
#pragma unroll
            for (int r = 0; r < 16; ++r) cin[r] = __builtin_fmaf(slope2, (float)((r & 3) + 8 * (r >> 2)), base);
            qkt(p0, p1, shm + L_K3 + slot * 2 * SLOTB, qr, cin, r32, hi);
            qkt(p2, p3, shm + L_K3 + slot * 2 * SLOTB + SLOTB, qr, cin, r32, hi);
            if (jb >= 0) {
#pragma unroll
                for (int r = 0; r < 16; ++r) { const int kv = 128 * jb + crow(r, hi);
                    if (kv > qrel) p0[r] = -INFINITY; if (kv + 32 > qrel) p1[r] = -INFINITY; if (kv + 64 > qrel) p2[r] = -INFINITY; if (kv + 96 > qrel) p3[r] = -INFINITY; }
            }
            float rm0 = p0[0], rm1 = p1[0], rm2 = p2[0], rm3 = p3[0];
#pragma unroll
            for (int r = 1; r < 16; ++r) { rm0 = fmaxf(rm0, p0[r]); rm1 = fmaxf(rm1, p1[r]); rm2 = fmaxf(rm2, p2[r]); rm3 = fmaxf(rm3, p3[r]); }
            float rm = fmaxf(fmaxf(rm0, rm1 + d32), fmaxf(rm2 + d64, rm3 + d96));
            rm = fmaxf(rm, __shfl_xor(rm, 32));
            const float mn = fmaxf(mrun, rm);
            if (__builtin_amdgcn_ballot_w64(mn > mrun) != 0ull) {
                const float alpha = ex2(mrun - mn); lrun *= alpha;
                if (hi == 0) wsf[r32] = alpha;
                asm volatile("s_waitcnt lgkmcnt(0)" ::: "memory");
#pragma unroll
                for (int r = 0; r < 16; ++r) { const float a = wsf[crow(r, hi)]; o[0][r] *= a; o[1][r] *= a; }
            }
            mrun = mn;
            const float mn1 = mn - d32, mn2 = mn - d64, mn3 = mn - d96; float sum = 0.f;
#pragma unroll
            for (int r = 0; r < 16; ++r) { p0[r] = ex2(p0[r] - mn); p1[r] = ex2(p1[r] - mn1); p2[r] = ex2(p2[r] - mn2); p3[r] = ex2(p3[r] - mn3); sum += (p0[r] + p1[r]) + (p2[r] + p3[r]); }
            lrun += sum;
            pv(o, vb0 + slot * 2 * SLOTB, pack8(p0, 0), pack8(p0, 8), pack8(p1, 0), pack8(p1, 8));
            pv(o, vb0 + slot * 2 * SLOTB + SLOTB, pack8(p2, 0), pack8(p2, 8), pack8(p3, 0), pack8(p3, 8));
        }
        { const float ub = slope2 * (float)(128 * (dt - 1) + 127 - (q0 + qrel)) + qn * kmax;
          const bool done = !asc && (dt <= 2 * own) && (__builtin_amdgcn_ballot_w64(!(ub < mrun - MB_EXIT)) == 0ull); wdone = done; if (lane == 0) flg[(it & 1) * 8 + wid] = done ? 1u : 0u; }
    }
    } else {
    for (int it = 0; it < ND; ++it) {
        const int dt = asc ? it : ND - 1 - it, slot = s3;
        if (it + 1 < ND) asm volatile("s_waitcnt vmcnt(4) lgkmcnt(0)\n\ts_barrier" ::: "memory");
        else ATT_WAIT_BAR();
        if (it > 0) { const LAS3 u32x4* f = (const LAS3 u32x4*)((LAS3 unsigned*)flg + ((it - 1) & 1) * 8); const u32x4 fa_ = f[0], fb_ = f[1]; const unsigned all = (fa_.x & fa_.y) & (fa_.z & fa_.w) & (fb_.x & fb_.y) & (fb_.z & fb_.w); if (__builtin_amdgcn_readfirstlane(all)) break; }
        if (it + 2 < ND) MB_DMA2(ksrc, vsrc, asc ? dt + 2 : dt - 2, (s3 == 0 ? 2 : s3 - 1));
        s3 = (s3 == 2) ? 0 : s3 + 1;
        const int pb = dt >> 1, jb = dt - 2 * own;
        const bool selme = (jb >= 0) || ((sel >> pb) & 1u);
        const bool active = !wdone && ((jb >= 0) ? (128 * jb <= 32 * wid + 31) : (__builtin_amdgcn_ballot_w64(selme) != 0ull));
        if (active && false) {
            const int istar = (jb >= 0) ? wid - 4 * jb : 4;
            const float basev = slope2 * (float)(128 * dt + 4 * hi - (q0 + qrel)) - Bq;
            const int kb = (int)(lds0 + L_K3) + slot * 2 * SLOTB + r32 * 128; const int ksw = (r32 >> 1) & 7;
            const int kbd[4] = {kb + (((0 + hi) ^ ksw) << 4), kb + (((2 + hi) ^ ksw) << 4), kb + (((4 + hi) ^ ksw) << 4), kb + (((6 + hi) ^ ksw) << 4)};
#define MB_KREAD(F, D0, OFF) asm volatile("ds_read_b128 %0,%1 offset:%c2" : "=&v"(F) : "v"(kbd[D0]), "i"(OFF) : "memory")
            bf16x8 fa[8], fb[8];
#pragma unroll
            for (int d0 = 0; d0 < 4; ++d0) { MB_KREAD(fa[2 * d0], d0, 0); MB_KREAD(fa[2 * d0 + 1], d0, 4096); }
            f32x16 p0, p1, p2, p3;
#define MB_CIN(P, I) do { const float bi_ = (selme && (I) <= istar) ? basev + (float)(I) * d32 : -INFINITY; \
                _Pragma("unroll") for (int r = 0; r < 16; ++r) P[r] = __builtin_fmaf(slope2, (float)((r & 3) + 8 * (r >> 2)), bi_); \
                if ((I) == istar) { _Pragma("unroll") for (int r = 0; r < 16; ++r) if (crow(r, hi) > r32) P[r] = -INFINITY; } } while (0)
            MB_CIN(p0, 0); MB_CIN(p1, 1); MB_CIN(p2, 2); MB_CIN(p3, 3);
#undef MB_CIN
            asm volatile("s_waitcnt lgkmcnt(0)" ::: "memory"); __builtin_amdgcn_sched_barrier(0);
#pragma unroll
            for (int d0 = 0; d0 < 4; ++d0) { MB_KREAD(fb[2 * d0], d0, SLOTB); MB_KREAD(fb[2 * d0 + 1], d0, SLOTB + 4096); }
            __builtin_amdgcn_sched_barrier(0);
#pragma unroll
            for (int d0 = 0; d0 < 4; ++d0) { p0 = __builtin_amdgcn_mfma_f32_32x32x16_bf16(fa[2 * d0], qr[d0], p0, 0, 0, 0); p1 = __builtin_amdgcn_mfma_f32_32x32x16_bf16(fa[2 * d0 + 1], qr[d0], p1, 0, 0, 0); }
            const int vb = vb0 + slot * 2 * SLOTB;
            s16x4 vlo[4], vhi[4], wlo[4], whi[4];
#define MB_VREADS(LO, HI, VB, D0) do { _Pragma("unroll") for (int ks = 0; ks < 4; ++ks) { \
                asm volatile("ds_read_b64_tr_b16 %0,%1 offset:%c2" : "=&v"(LO[ks]) : "v"(VB), "i"((D0) * 4096 + ks * 1024) : "memory"); \
                asm volatile("ds_read_b64_tr_b16 %0,%1 offset:%c2" : "=&v"(HI[ks]) : "v"(VB), "i"((D0) * 4096 + ks * 1024 + 512) : "memory"); } } while (0)
#define MB_LSUM(PA0, PA1, PA2, PA3) do { lvec = __builtin_amdgcn_mfma_f32_32x32x16_bf16(ONESA, PA0, lvec, 0, 0, 0); lvec = __builtin_amdgcn_mfma_f32_32x32x16_bf16(ONESA, PA1, lvec, 0, 0, 0); \
                lvec = __builtin_amdgcn_mfma_f32_32x32x16_bf16(ONESA, PA2, lvec, 0, 0, 0); lvec = __builtin_amdgcn_mfma_f32_32x32x16_bf16(ONESA, PA3, lvec, 0, 0, 0); } while (0)
#define MB_PK(LO, HI, k) (bf16x8){LO[k][0], LO[k][1], LO[k][2], LO[k][3], HI[k][0], HI[k][1], HI[k][2], HI[k][3]}
#define MB_PV(D0, LO, HI, PA0, PA1, PA2, PA3) do { \
                o[D0] = __builtin_amdgcn_mfma_f32_32x32x16_bf16(PA0, MB_PK(LO, HI, 0), o[D0], 0, 0, 0); o[D0] = __builtin_amdgcn_mfma_f32_32x32x16_bf16(PA1, MB_PK(LO, HI, 1), o[D0], 0, 0, 0); \
                o[D0] = __builtin_amdgcn_mfma_f32_32x32x16_bf16(PA2, MB_PK(LO, HI, 2), o[D0], 0, 0, 0); o[D0] = __builtin_amdgcn_mfma_f32_32x32x16_bf16(PA3, MB_PK(LO, HI, 3), o[D0], 0, 0, 0); } while (0)
            asm volatile("s_waitcnt lgkmcnt(0)" ::: "memory");
            MB_VREADS(vlo, vhi, vb, 0);
            __builtin_amdgcn_sched_barrier(0);
#pragma unroll
            for (int d0 = 0; d0 < 4; ++d0) { p2 = __builtin_amdgcn_mfma_f32_32x32x16_bf16(fb[2 * d0], qr[d0], p2, 0, 0, 0); p3 = __builtin_amdgcn_mfma_f32_32x32x16_bf16(fb[2 * d0 + 1], qr[d0], p3, 0, 0, 0); }
#pragma unroll
            for (int r = 0; r < 16; ++r) { p0[r] = ex2(p0[r]); p1[r] = ex2(p1[r]); }
            const bf16x8 a0 = pack8n(p0, 0), a1 = pack8n(p0, 8), a2 = pack8n(p1, 0), a3 = pack8n(p1, 8);
            __builtin_amdgcn_sched_barrier(0);
            asm volatile("s_waitcnt lgkmcnt(0)" ::: "memory");
            MB_VREADS(wlo, whi, vb, 1);
            __builtin_amdgcn_sched_barrier(0);
            MB_PV(0, vlo, vhi, a0, a1, a2, a3);
#pragma unroll
            for (int r = 0; r < 16; ++r) p2[r] = ex2(p2[r]);
            __builtin_amdgcn_sched_barrier(0);
            asm volatile("s_waitcnt lgkmcnt(0)" ::: "memory");
            MB_VREADS(vlo, vhi, vb + SLOTB, 0);
            __builtin_amdgcn_sched_barrier(0);
            MB_PV(1, wlo, whi, a0, a1, a2, a3);
            MB_LSUM(a0, a1, a2, a3);
#pragma unroll
            for (int r = 0; r < 16; ++r) p3[r] = ex2(p3[r]);
            const bf16x8 b0 = pack8n(p2, 0), b1 = pack8n(p2, 8), b2 = pack8n(p3, 0), b3 = pack8n(p3, 8);
            __builtin_amdgcn_sched_barrier(0);
            asm volatile("s_waitcnt lgkmcnt(0)" ::: "memory");
            MB_VREADS(wlo, whi, vb + SLOTB, 1);
            __builtin_amdgcn_sched_barrier(0);
            MB_PV(0, vlo, vhi, b0, b1, b2, b3);
            __builtin_amdgcn_sched_barrier(0);
            asm volatile("s_waitcnt lgkmcnt(0)" ::: "memory");
            __builtin_amdgcn_sched_barrier(0);
            MB_PV(1, wlo, whi, b0, b1, b2, b3);
            MB_LSUM(b0, b1, b2, b3);
#undef MB_PV
#undef MB_LSUM
#undef MB_PK
#undef MB_VREADS
#undef MB_KREAD
            mrun = Bq + lg2(lvec[0]);
        } else if (active) {
            f32x16 p0, p1, p2, p3, cin;
            const float base = selme ? slope2 * (float)(128 * dt + 4 * hi - (q0 + qrel)) : -INFINITY;
#pragma unroll
            for (int r = 0; r < 16; ++r) cin[r] = __builtin_fmaf(slope2, (float)((r & 3) + 8 * (r >> 2)), base);
            qkt(p0, p1, shm + L_K3 + slot * 2 * SLOTB, qr, cin, r32, hi);
            qkt(p2, p3, shm + L_K3 + slot * 2 * SLOTB + SLOTB, qr, cin, r32, hi);
            if (jb >= 0) {
#pragma unroll
                for (int r = 0; r < 16; ++r) { const int kv = 128 * jb + crow(r, hi);
                    if (kv > qrel) p0[r] = -INFINITY; if (kv + 32 > qrel) p1[r] = -INFINITY; if (kv + 64 > qrel) p2[r] = -INFINITY; if (kv + 96 > qrel) p3[r] = -INFINITY; }
            }
            float rm0 = p0[0], rm1 = p1[0], rm2 = p2[0], rm3 = p3[0];
#pragma unroll
            for (int r = 1; r < 16; ++r) { rm0 = fmaxf(rm0, p0[r]); rm1 = fmaxf(rm1, p1[r]); rm2 = fmaxf(rm2, p2[r]); rm3 = fmaxf(rm3, p3[r]); }
            float rm = fmaxf(fmaxf(rm0, rm1 + d32), fmaxf(rm2 + d64, rm3 + d96));
            rm = fmaxf(rm, __shfl_xor(rm, 32));
            const float mn = fmaxf(mrun, rm);
            if (__builtin_amdgcn_ballot_w64(mn > mrun) != 0ull) {
                const float alpha = ex2(mrun - mn); lrun *= alpha;
                if (hi == 0) wsf[r32] = alpha;
                asm volatile("s_waitcnt lgkmcnt(0)" ::: "memory");
#pragma unroll
                for (int r = 0; r < 16; ++r) { const float a = wsf[crow(r, hi)]; o[0][r] *= a; o[1][r] *= a; }
            }
            mrun = mn;
            const float mn1 = mn - d32, mn2 = mn - d64, mn3 = mn - d96; float sum = 0.f;
#pragma unroll
            for (int r = 0; r < 16; ++r) { p0[r] = ex2(p0[r] - mn); p1[r] = ex2(p1[r] - mn1); p2[r] = ex2(p2[r] - mn2); p3[r] = ex2(p3[r] - mn3); sum += (p0[r] + p1[r]) + (p2[r] + p3[r]); }
            lrun += sum;
            pv(o, vb0 + slot * 2 * SLOTB, pack8(p0, 0), pack8(p0, 8), pack8(p1, 0), pack8(p1, 8));
            pv(o, vb0 + slot * 2 * SLOTB + SLOTB, pack8(p2, 0), pack8(p2, 8), pack8(p3, 0), pack8(p3, 8));
        }
        { const float ub = slope2 * (float)(128 * (dt - 1) + 127 - (q0 + qrel)) + qn * kmax;
          const bool done = !asc && (dt <= 2 * own) && (__builtin_amdgcn_ballot_w64(!(ub < mrun - MB_EXIT)) == 0ull); wdone = done; if (lane == 0) flg[(it & 1) * 8 + wid] = done ? 1u : 0u; }
    }
    }
    lrun += __shfl_xor(lrun, 32);
    if (fast) lrun = lvec[0];
    if (hi == 0) wsf[32 + r32] = lrun;
    asm volatile("s_waitcnt lgkmcnt(0)" ::: "memory");
    float rli[16];
#pragma unroll
    for (int r = 0; r < 16; ++r) rli[r] = __builtin_amdgcn_rcpf(wsf[32 + crow(r, hi)]);
    ATT_WAIT_BAR();
    if (h < 7) { const int own1 = MB_OWN(h + 1); MB_DMA2(ksrc + (size_t)S * HD, vsrc + (size_t)S * HD, MB_ASC(h + 1) ? 0 : 2 * own1 + 1, 0);
#pragma unroll
        for (int d0 = 0; d0 < 4; ++d0) qr[d0] = *(const bf16x8*)((const char*)(Q + (rowbase + own1 * 256 + wid * 32) * AW + (h + 1) * HD) + qoff + d0 * 32); }
    store_o(o, rli, O + (rowbase + q0 + wid * 32) * AW + h * HD, shm, L_OST, wid, lane, r32, hi);
    asm volatile("s_waitcnt lgkmcnt(0)\n\ts_barrier" ::: "memory");
  }
    __builtin_amdgcn_s_setprio(0);
    ATT_WAIT_BAR();
#undef MB_OWN
#undef MB_ASC
#undef ksrc
#undef vsrc
#undef MB_DMA2
}
__device__ __forceinline__ void moba_kmean(int b, int h, const bf16_t* __restrict__ K, float* kmg, float* kmx, LAS3 unsigned char* shm) {
    int tid_ = threadIdx.x; asm volatile("" : "+v"(tid_)); const int tid = tid_, blk = tid >> 6, g = (tid >> 3) & 7, c = tid & 7;
    const bf16_t* kp = K + ((size_t)(b * NH + h) * S + blk * 256 + g) * HD + c * 8;
    float s[8]; float nmax = 0.f;
#pragma unroll
    for (int j = 0; j < 8; ++j) s[j] = 0.f;
    {
        u32x4 wv[32];
#pragma unroll
        for (int i = 0; i < 32; ++i) wv[i] = *(const u32x4*)(kp + (size_t)(8 * i) * HD);
        asm volatile("" ::: "memory");
#pragma unroll
        for (int i = 0; i < 32; ++i) { const u32x4 w = wv[i];
            const float e0 = __uint_as_float(w.x << 16), e1 = __uint_as_float(w.x & 0xffff0000u), e2 = __uint_as_float(w.y << 16), e3 = __uint_as_float(w.y & 0xffff0000u);
            const float e4 = __uint_as_float(w.z << 16), e5 = __uint_as_float(w.z & 0xffff0000u), e6 = __uint_as_float(w.w << 16), e7 = __uint_as_float(w.w & 0xffff0000u);
            s[0] += e0; s[1] += e1; s[2] += e2; s[3] += e3; s[4] += e4; s[5] += e5; s[6] += e6; s[7] += e7;
            float n2 = (e0 * e0 + e1 * e1) + (e2 * e2 + e3 * e3) + (e4 * e4 + e5 * e5) + (e6 * e6 + e7 * e7);
            n2 += __shfl_xor(n2, 1); n2 += __shfl_xor(n2, 2); n2 += __shfl_xor(n2, 4);
            nmax = fmaxf(nmax, n2); }
    }
#pragma unroll
    for (int of = 8; of < 64; of <<= 1) nmax = fmaxf(nmax, __shfl_xor(nmax, of));
    LAS3 float* red = (LAS3 float*)(shm + L_RED);
#pragma unroll
    for (int j = 0; j < 8; ++j) red[(blk * 8 + g) * 64 + c * 8 + j] = s[j];
    LAS3 float* nred = (LAS3 float*)(shm + L_WS);
    if ((tid & 63) == 0) nred[blk] = nmax;
    ATT_WAIT_BAR();
    { const int d = tid & 63; float a = 0.f;
#pragma unroll
      for (int gg = 0; gg < 8; ++gg) a += red[(blk * 8 + gg) * 64 + d];
      kmg[blk * 64 + d] = a * (1.f / 256.f);
      if (tid == 0) { float m = nred[0];
#pragma unroll
          for (int i = 1; i < 8; ++i) m = fmaxf(m, nred[i]);
          kmx[0] = __builtin_sqrtf(m) * 1.0001f; } }
    ATT_WAIT_BAR();
}
__device__ __forceinline__ void moba_stage_kmean(int b, const float* kmg_all, const float* kmx_all, LAS3 unsigned char* shm) {
    int tid_ = threadIdx.x; asm volatile("" : "+v"(tid_)); const int tid = tid_;
    LAS3 float* km = (LAS3 float*)(shm + L_KM);
    float kv[8];
#pragma unroll
    for (int i = 0; i < 8; ++i) kv[i] = kmg_all[(size_t)(b * 8 + i) * 512 + tid];
    asm volatile("" ::: "memory");
#pragma unroll
    for (int i = 0; i < 8; ++i) km[i * 512 + tid] = kv[i];
    if (tid < 8) ((LAS3 float*)(shm + L_KMX))[tid] = kmx_all[b * 8 + tid];
    ATT_WAIT_BAR();
}
__device__ __forceinline__ void conv_tile(int tile, const bf16_t* __restrict__ glu, const float* wdw, const float* bdw, const float* lng, const float* lnb, bf16_t* out, LAS3 unsigned char* shm) {
    int tid_ = threadIdx.x; asm volatile("" : "+v"(tid_)); const int tid = tid_, lane = tid & 63; const int wid = __builtin_amdgcn_readfirstlane(tid >> 6);
    const int m0 = tile * 256, t0 = m0 % S;
    typedef float f32x2 __attribute__((ext_vector_type(2)));
    f32x2 we[15], wo[15]; float w0, w30;
    { float w[CW];
#pragma unroll
      for (int j = 0; j < CW; ++j) w[j] = wdw[j * CC + tid];
#pragma unroll
      for (int k = 0; k < 15; ++k) { we[k] = f32x2{w[2 * k], w[2 * k + 1]}; wo[k] = f32x2{w[2 * k + 1], w[2 * k + 2]}; }
      w0 = w[0]; w30 = w[30]; }
    const float bias = bdw[tid];
    f32x4 g0 = *(const f32x4*)(lng + 8 * lane), g1 = *(const f32x4*)(lng + 8 * lane + 4), b0 = *(const f32x4*)(lnb + 8 * lane), b1 = *(const f32x4*)(lnb + 8 * lane + 4);
    f32x2 x2[31]; float xn[32];
    { float x[32 + CW - 1];
#pragma unroll
      for (int i = 0; i < 32 + CW - 1; ++i) { const int tt = i - (CW - 1); const int tc = (t0 + tt >= 0) ? tt : -t0;
          x[i] = __uint_as_float((unsigned)glu[(size_t)(m0 + tc) * CC + tid]); }
      asm volatile("" ::: "memory");
#pragma unroll
      for (int i = 0; i < 32 + CW - 1; ++i) { const int tt = i - (CW - 1); x[i] = (t0 + tt >= 0) ? __uint_as_float(__float_as_uint(x[i]) << 16) : 0.f; }
#pragma unroll
      for (int k = 0; k < 31; ++k) x2[k] = f32x2{x[2 * k], x[2 * k + 1]}; }
    for (int ch = 0; ch < 8; ++ch) {
        const int tb = 32 * ch;
        LAS3 float* tl = (LAS3 float*)(shm + L_CONV + (ch & 1) * 65536);
        if (ch < 7) {
#pragma unroll
            for (int i = 0; i < 32; ++i) xn[i] = __uint_as_float((unsigned)glu[(size_t)(m0 + tb + 32 + i) * CC + tid]);
            asm volatile("" ::: "memory");
        }
#pragma unroll
        for (int m = 0; m < 16; ++m) { f32x2 ae = f32x2{bias, 0.f}, ao = f32x2{bias, 0.f};
#pragma unroll
            for (int k = 0; k < 15; ++k) { ae = __builtin_elementwise_fma(we[k], x2[m + k], ae); ao = __builtin_elementwise_fma(wo[k], x2[m + k + 1], ao); }
            tl[(2 * m) * CC + tid] = (ae.x + ae.y) + w30 * x2[m + 15].x; tl[(2 * m + 1) * CC + tid] = (ao.x + ao.y) + w0 * x2[m].y; }
        ATT_WAIT_BAR();
#pragma unroll
        for (int k = 0; k < 4; ++k) { const int tok = 4 * wid + k;
            const f32x4 v0 = *(const LAS3 f32x4*)(tl + tok * CC + 8 * lane), v1 = *(const LAS3 f32x4*)(tl + tok * CC + 8 * lane + 4);
            float s = (v0[0] + v0[1]) + (v0[2] + v0[3]) + (v1[0] + v1[1]) + (v1[2] + v1[3]);
#pragma unroll
            for (int of = 1; of < 64; of <<= 1) s += __shfl_xor(s, of);
            const float mean = s * (1.f / CC); const f32x4 d0 = v0 - mean, d1 = v1 - mean;
            float q = (d0[0] * d0[0] + d0[1] * d0[1]) + (d0[2] * d0[2] + d0[3] * d0[3]) + (d1[0] * d1[0] + d1[1] * d1[1]) + (d1[2] * d1[2] + d1[3] * d1[3]);
#pragma unroll
            for (int of = 1; of < 64; of <<= 1) q += __shfl_xor(q, of);
            const float rstd = __builtin_amdgcn_rsqf(q * (1.f / CC) + EPS);
            f32x4 y0 = d0 * rstd * g0 + b0, y1 = d1 * rstd * g1 + b1;
#pragma unroll
            for (int e = 0; e < 4; ++e) { y0[e] = y0[e] * __builtin_amdgcn_rcpf(1.f + ex2(-LOG2E * y0[e])); y1[e] = y1[e] * __builtin_amdgcn_rcpf(1.f + ex2(-LOG2E * y1[e])); }
            u32x4 pk; pk.x = cvtpk(y0[0], y0[1]); pk.y = cvtpk(y0[2], y0[3]); pk.z = cvtpk(y1[0], y1[1]); pk.w = cvtpk(y1[2], y1[3]);
            *(u32x4*)(out + (size_t)(m0 + tb + tok) * CC + 8 * lane) = pk; }
#pragma unroll
        for (int k = 0; k < 15; ++k) x2[k] = x2[k + 16];
#pragma unroll
        for (int q = 0; q < 16; ++q) x2[15 + q] = f32x2{__uint_as_float(__float_as_uint(xn[2 * q]) << 16), __uint_as_float(__float_as_uint(xn[2 * q + 1]) << 16)};
    }
    ATT_WAIT_BAR();
}
#undef LAS3
}

#define GAS __attribute__((address_space(1)))
#define LAS __attribute__((address_space(3)))
typedef unsigned short bf16;
typedef unsigned v4u __attribute__((ext_vector_type(4)));
typedef float f32x4 __attribute__((ext_vector_type(4)));
typedef unsigned u32x2 __attribute__((ext_vector_type(2)));
typedef GAS unsigned gu32;
#define LDS_WAIT() asm volatile("s_waitcnt lgkmcnt(0)" ::: "memory")

#define XB_TMO      128
#define XB_XCNT(j)  (256  + 64 * (j))
#define XB_XSUB(j)  (1280 + 64 * (j))
#define XB_XGEN(j)  (2304 + 64 * (j))
#define XB_TOP      3328
#define XB_TOPGEN   3392
#define XCD_BAR_WORDS 3456
#define XB_SPIN_CAP (1u << 18)

__device__ __forceinline__ unsigned xb_ld(unsigned* p)              { return __hip_atomic_load(p, __ATOMIC_RELAXED, __HIP_MEMORY_SCOPE_AGENT); }
__device__ __forceinline__ unsigned xb_add(unsigned* p, unsigned v) { return __hip_atomic_fetch_add(p, v, __ATOMIC_RELAXED, __HIP_MEMORY_SCOPE_AGENT); }
__device__ __forceinline__ unsigned xb_xcc_id() { return (unsigned)__builtin_amdgcn_s_getreg((3 << 11) | 20) & 0xFu; }
#define XB_SPIN(cond, bar) do { unsigned _sp = 0; while (cond) { __builtin_amdgcn_s_sleep(1); \
    if ((++_sp & 255u) == 0u) { if (xb_ld(&(bar)[XB_TMO])) break; if (_sp > XB_SPIN_CAP) { atomicAdd(&(bar)[XB_TMO], 1u); break; } } } } while (0)

struct XcdBarrier {
    unsigned* bar; unsigned x;
    volatile LAS unsigned* st;
};

__device__ __forceinline__ XcdBarrier xcd_barrier_post(unsigned* bar, volatile LAS unsigned* st) {
    XcdBarrier b; b.bar = bar; b.x = xb_xcc_id(); b.st = st;
    if (threadIdx.x == 0) (void)xb_add(&bar[XB_XCNT(b.x)], 1u);
    return b;
}
__device__ __forceinline__ void xcd_barrier_complete(unsigned* bar, unsigned x, unsigned& nloc, unsigned& nx) {
    const unsigned G = gridDim.x * gridDim.y * gridDim.z;
    unsigned sum, cnt, mine, sp = 0u;
    for (;;) {
        sum = 0u; cnt = 0u; mine = 0u;
#pragma unroll
        for (unsigned j = 0; j < 16; ++j) { const unsigned c = xb_ld(&bar[XB_XCNT(j)]); sum += c; cnt += (c > 0u) ? 1u : 0u; mine = (j == x) ? c : mine; }
        if (sum == G) break;
        __builtin_amdgcn_s_sleep(1);
        if ((++sp & 255u) == 0u) { if (xb_ld(&bar[XB_TMO])) break; if (sp > XB_SPIN_CAP) { atomicAdd(&bar[XB_TMO], 1u); break; } }
    }
    nloc = mine > 0u ? mine : 1u; nx = cnt > 0u ? cnt : 1u;
}

__device__ __forceinline__ void xcd_barrier(const XcdBarrier& b) {
    asm volatile("s_waitcnt vmcnt(0)" ::: "memory");
    __syncthreads();
    if (threadIdx.x == 0) {
        unsigned* bar = b.bar;
        __builtin_amdgcn_s_waitcnt(0);
        unsigned nloc = b.st[0], nx = b.st[1];
        if (nloc == 0u) { xcd_barrier_complete(bar, b.x, nloc, nx); b.st[0] = nloc; b.st[1] = nx; }
        const unsigned old = xb_add(&bar[XB_XSUB(b.x)], 1u);
        const unsigned gen = old / nloc;
        if (old + 1u == (gen + 1u) * nloc) {
            __builtin_amdgcn_fence(__ATOMIC_RELEASE, "agent");
            asm volatile("s_waitcnt vmcnt(0)" ::: "memory");
            const unsigned og = xb_add(&bar[XB_TOP], 1u);
            const unsigned tg = og / nx;
            if (og + 1u == (tg + 1u) * nx) xb_add(&bar[XB_TOPGEN], 1u);
            else XB_SPIN(xb_ld(&bar[XB_TOPGEN]) == tg, bar);
            __builtin_amdgcn_fence(__ATOMIC_ACQUIRE, "agent");
            xb_add(&bar[XB_XGEN(b.x)], 1u);
            asm volatile("s_waitcnt vmcnt(0)" ::: "memory");
        } else {
            XB_SPIN(xb_ld(&bar[XB_XGEN(b.x)]) == gen, bar);
            __builtin_amdgcn_fence(__ATOMIC_ACQUIRE, "agent");
            asm volatile("s_waitcnt vmcnt(0)" ::: "memory");
        }
    }
    __syncthreads();
}

constexpr int NWAVES = 8;
constexpr int RING_OFF = 0, RING_BYTES = 131072;
constexpr int LDSCTL_OFF = RING_BYTES, MISC_OFF = LDSCTL_OFF + 320;
constexpr int LDS_BYTES = 147456;
constexpr int CW_BAR = 4096;
constexpr int MAX_LAUNCHES = 24;
static_assert((CW_BAR + MAX_LAUNCHES * XCD_BAR_WORDS) * 4 <= (int)WS_SSQ, "barrier words below the row statistics");
constexpr int N_PHASES = 18;

struct Args { const float* in[19]; float* out; unsigned char* ws; int ph_lo, ph_hi, li, pad; };

struct WDesc { const float* src; const float* gain; bf16* dst; int K, N, Nsrc, map; };
__device__ __forceinline__ int map_col(int map, int n) {
    if (map == 1) { const int pn = n >> 8, j = n & 255; return j < 128 ? 128 * pn + j : DFF + 128 * pn + (j - 128); }
    if (map == 2) { if (n < 3072 || n >= 4096) return n; const int pn = (n - 3072) >> 8, j = n & 255; return j < 128 ? 3072 + 128 * pn + j : 3072 + 512 + 128 * pn + (j - 128); }
    return n;
}
__device__ __forceinline__ WDesc get_wdesc(const Args& a, int wi) {
    const int l = wi / 9, k = wi % 9; unsigned char* wl = a.ws + WS_W + (size_t)l * W_LAYER; WDesc w;
    switch (k) {
    case 0: w = WDesc{a.in[2] + (size_t)l * D * NFF, a.in[1] + (size_t)l * D, (bf16*)(wl + W_F1I), D, NFF, NFF, 1}; break;
    case 1: w = WDesc{a.in[3] + (size_t)l * DFF * D, nullptr, (bf16*)(wl + W_F1O), DFF, D, D, 0}; break;
    case 2: w = WDesc{a.in[5] + (size_t)l * D * NIN, a.in[4] + (size_t)l * D, (bf16*)(wl + W_IN), D, NIN, NIN, 2}; break;
    case 3: w = WDesc{a.in[7] + (size_t)l * AW * D, nullptr, (bf16*)(wl + W_OUT3), AW, D, D, 0}; break;
    case 4: w = WDesc{a.in[8] + (size_t)l * AW * D, nullptr, (bf16*)(wl + W_OUT3 + 1 * MiB), AW, D, D, 0}; break;
    case 5: w = WDesc{a.in[13] + (size_t)l * CC * D, nullptr, (bf16*)(wl + W_OUT3 + 2 * MiB), CC, D, D, 0}; break;
    case 6: w = WDesc{a.in[14] + (size_t)l * D * D, nullptr, (bf16*)(wl + W_O), D, D, D, 0}; break;
    case 7: w = WDesc{a.in[16] + (size_t)l * D * NFF, a.in[15] + (size_t)l * D, (bf16*)(wl + W_F2I), D, NFF, NFF, 1}; break;
    default: w = WDesc{a.in[17] + (size_t)l * DFF * D, nullptr, (bf16*)(wl + W_F2O), DFF, D, D, 0}; break;
    }
    return w;
}
__device__ __forceinline__ void transpose_load(const WDesc& w, int item, int lane, float (&tv)[32], float (&gv)[8]) {
    const int nblk = w.N / 32, kb = item / nblk, nb = item % nblk, k0 = 64 * kb, n0 = 32 * nb;
    const int s0 = map_col(w.map, n0);
#pragma unroll
    for (int i = 0; i < 8; ++i) { const f32x4 t = *(const f32x4*)(w.src + (size_t)(k0 + 8 * i + (lane >> 3)) * w.Nsrc + s0 + 4 * (lane & 7));
        tv[4 * i] = t.x; tv[4 * i + 1] = t.y; tv[4 * i + 2] = t.z; tv[4 * i + 3] = t.w; }
    if (w.gain) {
#pragma unroll
        for (int i = 0; i < 8; ++i) gv[i] = w.gain[k0 + 8 * i + (lane >> 3)]; }
    else {
#pragma unroll
        for (int i = 0; i < 8; ++i) gv[i] = 1.f; }
}
__device__ __forceinline__ void transpose_finish(const WDesc& w, LAS float* scr, int item, int lane, const float (&tv)[32], const float (&gv)[8]) {
    const int nblk = w.N / 32, kb = item / nblk, nb = item % nblk, k0 = 64 * kb, n0 = 32 * nb;
#pragma unroll
    for (int i = 0; i < 8; ++i)
#pragma unroll
        for (int e = 0; e < 4; ++e) scr[(8 * i + (lane >> 3)) * 33 + 4 * (lane & 7) + e] = tv[4 * i + e] * gv[i];
    LDS_WAIT(); asm volatile("" ::: "memory");
    const int c = lane & 7;
#pragma unroll
    for (int j = 0; j < 4; ++j) { const int n = (lane >> 3) + 8 * j; const LAS float* s = scr + (8 * c) * 33 + n;
        v4u o; o.x = pg8::cvt_pk_bf16(s[0 * 33], s[1 * 33]); o.y = pg8::cvt_pk_bf16(s[2 * 33], s[3 * 33]); o.z = pg8::cvt_pk_bf16(s[4 * 33], s[5 * 33]); o.w = pg8::cvt_pk_bf16(s[6 * 33], s[7 * 33]);
        *(GAS v4u*)(w.dst + (size_t)(n0 + n) * w.K + k0 + 8 * c) = o; }
    LDS_WAIT(); asm volatile("" ::: "memory");
}
__device__ __forceinline__ void locate_item(int g, int& wi, int& loc) {
    constexpr int C0 = (D / 64) * (NFF / 32), C1 = (DFF / 64) * (D / 32), C2 = (D / 64) * (NIN / 32), C3 = (AW / 64) * (D / 32), C6 = (D / 64) * (D / 32), T = 2 * C0 + 2 * C1 + C2 + 3 * C3 + C6;
    const int l = g / T; int r = g - l * T; int k = 0;
    if (r >= C0) { r -= C0; k = 1; if (r >= C1) { r -= C1; k = 2; if (r >= C2) { r -= C2; k = 3; if (r >= C3) { r -= C3; k = 4; if (r >= C3) { r -= C3; k = 5; if (r >= C3) { r -= C3; k = 6; if (r >= C6) { r -= C6; k = 7; if (r >= C0) { r -= C0; k = 8; } } } } } } } }
    wi = 9 * l + k; loc = r;
}
constexpr int PRO_ITEMS = 2 * (2 * (D / 64) * (NFF / 32) + 2 * (DFF / 64) * (D / 32) + (D / 64) * (NIN / 32) + 3 * (AW / 64) * (D / 32) + (D / 64) * (D / 32));
__device__ __forceinline__ float wave_sum(float v) {
#pragma unroll
    for (int o = 1; o < 64; o <<= 1) v += __shfl_xor(v, o);
    return v;
}

__global__ void __launch_bounds__(NWAVES * 64, 2) mk_fwd(Args args) {
    extern __shared__ __attribute__((aligned(16))) unsigned char lds[];
    LAS unsigned char* const L = (LAS unsigned char*)lds;
    volatile LAS unsigned* const MISC = (volatile LAS unsigned*)(L + MISC_OFF);
    const int tid = threadIdx.x;
    const int G = gridDim.x; const int vcu = (G % 8 == 0) ? ((int)blockIdx.x % 8) * (G / 8) + (int)blockIdx.x / 8 : (int)blockIdx.x;
    unsigned char* const ws = args.ws;
    gu32* const ctl = (gu32*)(ws + WS_CTL);
    for (int u = tid; u < (LDS_BYTES - LDSCTL_OFF) / 4; u += NWAVES * 64) ((LAS unsigned*)(L + LDSCTL_OFF))[u] = 0u;
    __syncthreads();
    XcdBarrier bar = xcd_barrier_post((unsigned*)(ctl + CW_BAR) + args.li * XCD_BAR_WORDS, MISC + 8);
    const int lo = args.ph_lo, hi = args.ph_hi;
#define IN(k) (lo <= (k) && (k) < hi)
#define SEAM(k) do { if (IN(k) && IN((k) + 1)) xcd_barrier(bar); } while (0)
    bf16* const Hh = (bf16*)(ws + WS_H); bf16* const ACT = (bf16*)(ws + WS_ACT);
    bf16* const QA = (bf16*)(ws + WS_QA); bf16* const KA = (bf16*)(ws + WS_KA); bf16* const VA = (bf16*)(ws + WS_VA);
    bf16* const QB = (bf16*)(ws + WS_QB); bf16* const KB = (bf16*)(ws + WS_KB); bf16* const VB = (bf16*)(ws + WS_VB);
    bf16* const GLU = (bf16*)(ws + WS_GLU); bf16* const CONVO = (bf16*)(ws + WS_CONVO); bf16* const GC = (bf16*)(ws + WS_GC); bf16* const MIXED = (bf16*)(ws + WS_MIXED);
    bf16* const GA = (bf16*)args.out; bf16* const GB = (bf16*)args.out + (size_t)M * D;
    unsigned* const ssq = (unsigned*)(ws + WS_SSQ);

    if (IN(0)) {
        int tl_ = threadIdx.x; asm volatile("" : "+v"(tl_)); const int lane = tl_ & 63, wave = __builtin_amdgcn_readfirstlane(tl_ >> 6);
        LAS float* scr = (LAS float*)(L + RING_OFF + wave * 16384);
        const int gw = vcu * NWAVES + wave, NGW = G * NWAVES;
        {
        {
            float ta[32], ga[8], tb[32], gb[8]; int wia, la, wib, lb; int g = gw;
            if (g < PRO_ITEMS) { locate_item(g, wia, la); const WDesc w = get_wdesc(args, wia); transpose_load(w, la, lane, ta, ga); }
            while (g < PRO_ITEMS) {
                const bool hb = g + NGW < PRO_ITEMS;
                if (hb) { locate_item(g + NGW, wib, lb); const WDesc w = get_wdesc(args, wib); transpose_load(w, lb, lane, tb, gb); }
                { const WDesc w = get_wdesc(args, wia); transpose_finish(w, scr, la, lane, ta, ga); }
                g += NGW; if (!hb) break;
                const bool ha = g + NGW < PRO_ITEMS;
                if (ha) { locate_item(g + NGW, wia, la); const WDesc w = get_wdesc(args, wia); transpose_load(w, la, lane, ta, ga); }
                { const WDesc w = get_wdesc(args, wib); transpose_finish(w, scr, lb, lane, tb, gb); }
                g += NGW; if (!ha) break;
            }
        }
        const float* x = args.in[0];
        for (int m4 = gw * 4; m4 < M; m4 += NGW * 4) {
            f32x4 v[4][4];
#pragma unroll
            for (int rr4 = 0; rr4 < 4; ++rr4)
#pragma unroll
                for (int j = 0; j < 4; ++j) v[rr4][j] = *((const GAS f32x4*)(x + (size_t)(m4 + rr4) * D) + lane + 64 * j);
#pragma unroll
            for (int rr4 = 0; rr4 < 4; ++rr4) { float s = 0.f;
#pragma unroll
                for (int j = 0; j < 4; ++j) { const f32x4 t = v[rr4][j]; s += (t.x * t.x + t.y * t.y) + (t.z * t.z + t.w * t.w);
                    u32x2 o; o.x = pg8::cvt_pk_bf16(t.x, t.y); o.y = pg8::cvt_pk_bf16(t.z, t.w); *((GAS u32x2*)(Hh + (size_t)(m4 + rr4) * D) + lane + 64 * j) = o; }
                s = wave_sum(s);
                if (lane == 0) ssq[m4 + rr4] = (unsigned)(s * SSQ_FIX + 0.5f); }
        }
        }
    }
    SEAM(0);

    for (int l = 0; l < DEPTH; ++l) {
        const int pb = 1 + 8 * l;
        unsigned char* const wl = ws + WS_W + (size_t)l * W_LAYER;
        for (int half = 0; half < 2; ++half) {
            if (IN(pb + 6 * half)) {
                pg8::Gemm g{Hh, (const bf16*)(wl + (half ? W_F2I : W_F1I)), M, NFF, D}; pg8::StaticOrder So; So.init(M, NFF, G, (int)blockIdx.x);
                pg8::EpiSwiglu E{ACT, pg8::RowScale{ssq + (size_t)(3 * l + 2 * half) * M, 0u, 0u}, L};
                pg8::gemm_phase<pg8::EpiSwiglu, pg8::StaticOrder, true, true>(L + RING_OFF, g, So, E);
            }
            SEAM(pb + 6 * half);
            if (IN(pb + 1 + 6 * half)) {
                pg8::Gemm g{ACT, (const bf16*)(wl + (half ? W_F2O : W_F1O)), M, D, DFF}; pg8::StaticOrder So; So.init(M, D, G, (int)blockIdx.x);
                { pg8::EpiRes E{Hh, ssq + (size_t)(3 * l + 1 + 2 * half) * M, 0.5f};
                pg8::gemm_phase<pg8::EpiRes, pg8::StaticOrder, true, true>(L + RING_OFF, g, So, E); }
            }
            SEAM(pb + 1 + 6 * half);
            if (half == 0) {
                if (IN(pb + 2)) {
                    pg8::Gemm g{Hh, (const bf16*)(wl + W_IN), M, NIN, D}; pg8::StaticOrder So; So.init(M, NIN, G, (int)blockIdx.x);
                    pg8::EpiWin E{QA, GLU, GA, GB, GC, args.in[6] + (size_t)l * 3 * D, pg8::RowScale{ssq + (size_t)(3 * l + 1) * M, 0u, 0u}, L};
                    pg8::gemm_phase<pg8::EpiWin, pg8::StaticOrder, true, true>(L + RING_OFF, g, So, E);
                }
                SEAM(pb + 2);
                if (IN(pb + 3)) {
                    float* const KMG = (float*)(ws + WS_KMEAN); float* const KMX = KMG + 256 * 512;
                    for (int bh = vcu; bh < NB * NH; bh += G) att::moba_kmean(bh >> 3, bh & 7, KB, KMG + (size_t)bh * 512, KMX + bh, L + RING_OFF);
                    xcd_barrier(bar);
                    for (int bh = vcu; bh < NB * NH; bh += G) { const int b = bh >> 3, h = bh & 7;
                        att::sb_units(b, h, QA, KA, VA, QA, L + RING_OFF); }
                    for (int tile = vcu; tile < M / 256; tile += G)
                        att::conv_tile(tile, GLU, args.in[9] + (size_t)l * CW * CC, args.in[10] + (size_t)l * CC, args.in[11] + (size_t)l * CC, args.in[12] + (size_t)l * CC, CONVO, L + RING_OFF);
                    {
                        for (int bj = vcu; bj < NB * 8; bj += G) { const int b = bj >> 3, j = bj & 7;
                            att::moba_stage_kmean(b, KMG, KMX, L + RING_OFF);
                            att::moba_units(b, j, QB, KB, VB, QB, L + RING_OFF); }
                    }
                }
                SEAM(pb + 3);
                if (IN(pb + 4)) {
                    pg8::Gemm g{QA, (const bf16*)(wl + W_OUT3), 3 * M, 3 * D, AW}; pg8::MixOrder So; So.base.init(M, D, G, (int)blockIdx.x);
                    pg8::EpiMix E{GA, GB, GC, MIXED};
                    pg8::gemm_phase<pg8::EpiMix, pg8::MixOrder, true, true>(L + RING_OFF, g, So, E);
                }
                SEAM(pb + 4);
                if (IN(pb + 5)) {
                    pg8::Gemm g{MIXED, (const bf16*)(wl + W_O), M, D, D}; pg8::StaticOrder So; So.init(M, D, G, (int)blockIdx.x);
                    { pg8::EpiRes E{Hh, ssq + (size_t)(3 * l + 2) * M, 1.0f};
                    pg8::gemm_phase<pg8::EpiRes, pg8::StaticOrder, true, true>(L + RING_OFF, g, So, E); }
                }
                SEAM(pb + 5);
            }
        }
    }
    if (IN(17)) {
        int tl_ = threadIdx.x; asm volatile("" : "+v"(tl_)); const int lane = tl_ & 63, wave = __builtin_amdgcn_readfirstlane(tl_ >> 6);
        const int gw = vcu * NWAVES + wave, NGW = G * NWAVES; const float* gn = args.in[18];
        f32x4 gv[4];
#pragma unroll
        for (int j = 0; j < 4; ++j) gv[j] = *((const GAS f32x4*)gn + lane + 64 * j);
        for (int m4 = gw * 4; m4 < M; m4 += NGW * 4) {
            u32x2 raw[4][4];
#pragma unroll
            for (int rr4 = 0; rr4 < 4; ++rr4)
#pragma unroll
                for (int j = 0; j < 4; ++j) raw[rr4][j] = *((const GAS u32x2*)(Hh + (size_t)(m4 + rr4) * D) + lane + 64 * j);
            asm volatile("" ::: "memory");
#pragma unroll
            for (int rr4 = 0; rr4 < 4; ++rr4) { float v[16]; float s = 0.f;
#pragma unroll
                for (int j = 0; j < 4; ++j) { const u32x2 w = raw[rr4][j];
                    v[4 * j + 0] = __uint_as_float(w.x << 16); v[4 * j + 1] = __uint_as_float(w.x & 0xffff0000u); v[4 * j + 2] = __uint_as_float(w.y << 16); v[4 * j + 3] = __uint_as_float(w.y & 0xffff0000u);
                    s += (v[4 * j] * v[4 * j] + v[4 * j + 1] * v[4 * j + 1]) + (v[4 * j + 2] * v[4 * j + 2] + v[4 * j + 3] * v[4 * j + 3]); }
                s = wave_sum(s);
                const float rs = __builtin_amdgcn_rsqf(s * (1.f / D) + EPS);
#pragma unroll
                for (int j = 0; j < 4; ++j) { f32x4 o; o.x = v[4 * j] * rs * gv[j].x; o.y = v[4 * j + 1] * rs * gv[j].y; o.z = v[4 * j + 2] * rs * gv[j].z; o.w = v[4 * j + 3] * rs * gv[j].w;
                    *((GAS f32x4*)(args.out + (size_t)(m4 + rr4) * D) + lane + 64 * j) = o; } }
        }
    }
#undef IN
#undef SEAM
}

static void launch_range(const Args& base, int lo, int hi, int& li, int grid, hipStream_t stream) {
    Args a = base; a.ph_lo = lo; a.ph_hi = hi; a.li = li++;
    hipLaunchKernelGGL(mk_fwd, dim3(grid), dim3(NWAVES * 64), LDS_BYTES, stream, a);
    const hipError_t le = hipPeekAtLastError();
    if (le != hipSuccess) fprintf(stderr, "kernel_launch: launch [%d,%d) failed: %s\n", lo, hi, hipGetErrorName(le));
}
extern "C" void kernel_launch(void* const* d_in, const int* in_sizes, int n_in, void* d_out, int out_size, void* d_ws, size_t ws_size, hipStream_t stream) {
    static int grid = 0;
    if (grid == 0) {
        if (n_in != 19 || in_sizes[0] != M * D || out_size != M * D || ws_size < WS_END) { fprintf(stderr, "kernel_launch: unexpected shapes (n_in %d out %d ws %zu); nothing launched\n", n_in, out_size, ws_size); grid = -1; return; }
        int dev = 0, cus = 0, per_cu = 0;
        if (hipGetDevice(&dev) != hipSuccess || hipDeviceGetAttribute(&cus, hipDeviceAttributeMultiprocessorCount, dev) != hipSuccess) { grid = -1; return; }
        if (hipFuncSetAttribute((const void*)mk_fwd, hipFuncAttributeMaxDynamicSharedMemorySize, LDS_BYTES) != hipSuccess) { fprintf(stderr, "kernel_launch: hipFuncSetAttribute failed\n"); grid = -1; return; }
        if (hipOccupancyMaxActiveBlocksPerMultiprocessor(&per_cu, (const void*)mk_fwd, NWAVES * 64, LDS_BYTES) != hipSuccess || per_cu < 1) { fprintf(stderr, "kernel_launch: occupancy query reports %d workgroups per CU\n", per_cu); }
        (void)hipGetLastError();
        grid = cus;
    }
    if (grid < 0) return;
    if (hipMemsetAsync((char*)d_ws + WS_CTL, 0, CTL_BYTES, stream) != hipSuccess) return;
    Args a{};
    for (int i = 0; i < 19; ++i) a.in[i] = (const float*)d_in[i];
    a.out = (float*)d_out; a.ws = (unsigned char*)d_ws;
    int li = 0;
    launch_range(a, 0, N_PHASES, li, grid, stream);
}
```
